# Optimizing an MI355X kernel written in HIP

```python
import math, functools
import jax, jax.numpy as jnp
from jax import lax
import numpy as np

D_MODEL = 1024
BATCH = 16
SEQ = 256
DEPTH = 2
DEC_BATCH = 2
DEC_SEQ = 1024
PAST_LEN = 512

GRID_W = 64
MIX_W = D_MODEL
S5_W = D_MODEL // 4
S5_H = 16
S5_G = S5_W // S5_H
S5_P = 64
HG_W = D_MODEL // 4
HG_DK = 64
HG_DV = 64
HG_H = HG_W // HG_DK
HG_CHUNK = 16
NA_W = D_MODEL // 2
NA_D = 64
NA_H = NA_W // NA_D
NA_KH = 8
NA_KW = 16
Q_BLOCK = 128
D_FF = 4 * D_MODEL
IN_W = S5_W + 5 * HG_W + 3 * NA_W
EPS = 1e-6
NEG_INF = -1e30

kernel_name = 'hybrid_s5_hgrn2_natten_prefix_flow_step'


def rms_norm(x, g):
    x32 = x.astype(jnp.float32)
    y = x32 * lax.rsqrt(jnp.mean(jnp.square(x32), axis=-1, keepdims=True) + EPS)
    return (y * g.astype(jnp.float32)).astype(x.dtype)


def _split_in(z):
    sizes = (S5_W, HG_W, HG_W, HG_W, HG_W, HG_W, NA_W, NA_W, NA_W)
    idx = np.cumsum(sizes)[:-1].tolist()
    return jnp.split(z, idx, axis=-1)


def _lin_rec_op(e1, e2):
    a1, b1 = e1
    a2, b2 = e2
    return a2 * a1, a2 * b1 + b2


def s5_mixer(u, l, P, s_init):
    B, L, _ = u.shape
    f32 = jnp.float32
    u32 = u.astype(f32)
    ug = u32.reshape(B, L, S5_G, S5_H).astype(jnp.complex64)
    y = P['s5_d'][l].astype(f32) * u32
    finals = []
    for d in range(2):
        a = lax.complex(P['s5_a_re'][l, d].astype(f32), P['s5_a_im'][l, d].astype(f32))
        dt = jnp.exp(P['s5_log_dt'][l, d].astype(f32))[:, None]
        a_bar = jnp.exp(a * dt)
        b_mat = lax.complex(P['s5_b_re'][l, d].astype(f32), P['s5_b_im'][l, d].astype(f32))
        b_bar = ((a_bar - 1.0) / a)[..., None] * b_mat
        c_mat = lax.complex(P['s5_c_re'][l, d].astype(f32), P['s5_c_im'][l, d].astype(f32))
        bu = jnp.einsum('blgh,gph->blgp', ug, b_bar)
        s0 = lax.complex(s_init[:, d, ..., 0].astype(f32), s_init[:, d, ..., 1].astype(f32))
        edge = L - 1 if d == 1 else 0
        bu = bu.at[:, edge].add(a_bar * s0)
        _, s = lax.associative_scan(_lin_rec_op, (jnp.broadcast_to(a_bar, bu.shape), bu),
                                    axis=1, reverse=(d == 1))
        y = y + jnp.real(jnp.einsum('blgp,ghp->blgh', s, c_mat)).reshape(B, L, S5_W)
        fin = s[:, edge]
        finals.append(jnp.stack([jnp.real(fin), jnp.imag(fin)], axis=-1))
    xg = jax.nn.gelu(y)
    out = xg * jax.nn.sigmoid(xg @ P['s5_w_glu'][l].astype(f32) + P['s5_b_glu'][l].astype(f32))
    return out.astype(u.dtype), jnp.stack(finals, axis=1)


def gla_chunked(q, k, v, logf, s0):
    B, L, H, dk = q.shape
    dv = v.shape[-1]
    nc = L // HG_CHUNK
    q, k, logf = (t.reshape(B, nc, HG_CHUNK, H, dk) for t in (q, k, logf))
    v = v.reshape(B, nc, HG_CHUNK, H, dv)
    b = jnp.cumsum(logf, axis=2)
    b_last = b[:, :, -1]
    causal = jnp.tril(jnp.ones((HG_CHUNK, HG_CHUNK), dtype=bool))[:, :, None, None]
    decay = jnp.exp(jnp.where(causal, b[:, :, :, None] - b[:, :, None], -jnp.inf))
    att = jnp.einsum('bntshd,bnthd,bnshd->bnhts', decay, q, k)
    o_intra = jnp.einsum('bnhts,bnshe->bnthe', att, v)
    k_to_end = k * jnp.exp(b_last[:, :, None] - b)
    kv = jnp.einsum('bnshd,bnshe->bnhde', k_to_end, v)

    def step(S, inp):
        dec, kv_c = inp
        return dec[..., None] * S + kv_c, S

    s_fin, s_start = lax.scan(step, s0, (jnp.swapaxes(jnp.exp(b_last), 0, 1), jnp.swapaxes(kv, 0, 1)))
    s_start = jnp.swapaxes(s_start, 0, 1)
    o_inter = jnp.einsum('bnthd,bnhde->bnthe', q * jnp.exp(b), s_start)
    return (o_intra + o_inter).reshape(B, L, H, dv), s_fin


def hgrn2_mixer(hq, hff, hfb, hi, hgate, l, P, s_init):
    B, L, _ = hq.shape
    f32 = jnp.float32
    lb_all = jnp.cumsum(jax.nn.softmax(P['hg_lb'].astype(f32), axis=0), axis=0)
    lb = (lb_all - lb_all[0])[l]
    shp = (B, L, HG_H, HG_DK)
    q = jax.nn.silu(hq.astype(f32)).reshape(shp)
    v = hi.astype(f32).reshape(B, L, HG_H, HG_DV)
    o = jnp.zeros((B, L, HG_H, HG_DV), f32)
    finals = []
    for d, zf in enumerate((hff, hfb)):
        f = (lb + (1.0 - lb) * jax.nn.sigmoid(zf.astype(f32))).reshape(shp)
        logf = jnp.log(f)
        k = 1.0 - f
        qd, kd, vd, lfd = q, k, v, logf
        if d == 1:
            qd, kd, vd, lfd = (jnp.flip(t, axis=1) for t in (qd, kd, vd, lfd))
        od, sd = gla_chunked(qd, kd, vd, lfd, s_init[:, d].astype(f32))
        if d == 1:
            od = jnp.flip(od, axis=1)
        o = o + od
        finals.append(sd)
    o = rms_norm(o, P['hg_norm'][l]).reshape(B, L, HG_W) * jax.nn.silu(hgate.astype(f32))
    return o.astype(hq.dtype), jnp.stack(finals, axis=1)


def ctx_attention(q, k, v):
    B, Lc, H, dh = q.shape
    nb = Lc // Q_BLOCK
    scale = dh ** -0.5
    qb = jnp.transpose(q.reshape(B, nb, Q_BLOCK, H, dh), (1, 0, 2, 3, 4))

    def blk(qi):
        s = jnp.einsum('bqhd,bkhd->bhqk', qi, k).astype(jnp.float32) * scale
        p = jax.nn.softmax(s, axis=-1).astype(v.dtype)
        return jnp.einsum('bhqk,bkhd->bqhd', p, v)

    o = lax.map(blk, qb)
    return jnp.transpose(o, (1, 0, 2, 3, 4)).reshape(B, Lc, H * dh)


def na_latent(q, k, v, k_ctx, v_ctx, rpb):
    B, L, H, dh = q.shape
    rows = L // GRID_W
    kh = min(NA_KH, rows)
    scale = dh ** -0.5
    qg = q.reshape(B, rows, GRID_W, H, dh)
    kg = k.reshape(B, rows, GRID_W, H, dh)
    vg = v.reshape(B, rows, GRID_W, H, dh)
    col = jnp.arange(GRID_W)
    c_start = jnp.clip(col - NA_KW // 2, 0, GRID_W - NA_KW)
    in_win = (col[None, :] >= c_start[:, None]) & (col[None, :] < c_start[:, None] + NA_KW)
    dc_idx = jnp.clip(col[None, :] - col[:, None] + NA_KW - 1, 0, 2 * NA_KW - 2)
    col_bias = rpb.astype(jnp.float32)[:, :, dc_idx]

    def one_row(r):
        r_start = jnp.clip(r - kh // 2, 0, rows - kh)
        q_r = lax.dynamic_index_in_dim(qg, r, axis=1, keepdims=False)
        k_r = lax.dynamic_slice_in_dim(kg, r_start, kh, axis=1)
        v_r = lax.dynamic_slice_in_dim(vg, r_start, kh, axis=1)
        dr_idx = r_start + jnp.arange(kh) - r + NA_KH - 1
        bias = jnp.transpose(col_bias[:, dr_idx], (0, 2, 1, 3))
        s_win = jnp.einsum('bqhd,bakhd->bhqak', q_r, k_r).astype(jnp.float32) * scale + bias
        s_win = jnp.where(in_win[:, None, :], s_win, NEG_INF)
        s_ctx = jnp.einsum('bqhd,bchd->bhqc', q_r, k_ctx).astype(jnp.float32) * scale
        s = jnp.concatenate([s_win.reshape(B, H, GRID_W, kh * GRID_W), s_ctx], axis=-1)
        p = jax.nn.softmax(s, axis=-1).astype(v.dtype)
        p_win = p[..., :kh * GRID_W].reshape(B, H, GRID_W, kh, GRID_W)
        p_ctx = p[..., kh * GRID_W:]
        return (jnp.einsum('bhqak,bakhd->bqhd', p_win, v_r)
                + jnp.einsum('bhqc,bchd->bqhd', p_ctx, v_ctx))

    o = lax.map(one_row, jnp.arange(rows))
    return jnp.transpose(o, (1, 0, 2, 3, 4)).reshape(B, L, H * dh)


def _ada(cvec, l, P):
    return jax.nn.silu(cvec) @ P['w_ada'][l] + P['b_ada'][l]


def _layer(x, m, l, P, s5_init, hg_init, na_fn):
    B, L, _ = x.shape
    sh1, sc1, g1, sh2, sc2, g2 = jnp.split(m, 6, axis=-1)
    h = rms_norm(x, P['norm_mix'][l]) * (1.0 + sc1) + sh1
    u, hq, hff, hfb, hi, hgate, nq, nk, nv = _split_in(h @ P['w_in'][l])
    y_s5, s5_fin = s5_mixer(u, l, P, s5_init)
    y_hg, hg_fin = hgrn2_mixer(hq, hff, hfb, hi, hgate, l, P, hg_init)
    k = nk.reshape(B, L, NA_H, NA_D)
    v = nv.reshape(B, L, NA_H, NA_D)
    y_na = na_fn(nq.reshape(B, L, NA_H, NA_D), k, v)
    mix = jnp.concatenate([y_s5, y_hg, y_na.astype(x.dtype)], axis=-1) @ P['w_out'][l]
    x = x + g1 * mix
    h2 = rms_norm(x, P['norm_mlp'][l]) * (1.0 + sc2) + sh2
    x = x + g2 * (jnp.square(jax.nn.relu(h2 @ P['w_mlp1'][l])) @ P['w_mlp2'][l])
    return x, k, v, s5_fin, hg_fin


def setup_inputs(seed: int = 0) -> dict:
    key = jax.random.key(seed)
    ks = iter(jax.random.split(key, 40))
    f32 = jnp.float32

    def nrm(shape, scale=1.0):
        return scale * jax.random.normal(next(ks), shape, f32)

    return {
        'x_prompt': nrm((BATCH, SEQ, D_MODEL)),
        'x_sample': nrm((DEC_BATCH, DEC_SEQ, D_MODEL)),
        'cache_k': nrm((DEC_BATCH, DEPTH, PAST_LEN, NA_H, NA_D)),
        'cache_v': nrm((DEC_BATCH, DEPTH, PAST_LEN, NA_H, NA_D)),
        'state_s5': nrm((DEC_BATCH, DEPTH, 2, S5_G, S5_P, 2), 0.5),
        'state_hgrn': nrm((DEC_BATCH, DEPTH, 2, HG_H, HG_DK, HG_DV), 0.5),
        'c': nrm((DEC_BATCH, D_MODEL)),
        'c_ctx': nrm((D_MODEL,)),
        'w_ada': nrm((DEPTH, D_MODEL, 6 * D_MODEL), 0.5 * D_MODEL ** -0.5),
        'b_ada': nrm((DEPTH, 6 * D_MODEL), 0.01),
        'norm_mix': 1.0 + nrm((DEPTH, D_MODEL), 0.01),
        'norm_mlp': 1.0 + nrm((DEPTH, D_MODEL), 0.01),
        'w_in': nrm((DEPTH, D_MODEL, IN_W), D_MODEL ** -0.5),
        'w_out': nrm((DEPTH, MIX_W, D_MODEL), MIX_W ** -0.5),
        's5_a_re': -0.5 + nrm((DEPTH, 2, S5_G, S5_P), 0.01),
        's5_a_im': jnp.pi * jnp.arange(S5_P, dtype=f32) + nrm((DEPTH, 2, S5_G, S5_P), 0.01),
        's5_b_re': nrm((DEPTH, 2, S5_G, S5_P, S5_H), (2 * S5_H) ** -0.5),
        's5_b_im': nrm((DEPTH, 2, S5_G, S5_P, S5_H), (2 * S5_H) ** -0.5),
        's5_c_re': nrm((DEPTH, 2, S5_G, S5_H, S5_P), S5_P ** -0.5),
        's5_c_im': nrm((DEPTH, 2, S5_G, S5_H, S5_P), S5_P ** -0.5),
        's5_log_dt': jax.random.uniform(next(ks), (DEPTH, 2, S5_G), f32,
                                        minval=math.log(1e-3), maxval=math.log(1e-1)),
        's5_d': nrm((DEPTH, S5_W)),
        's5_w_glu': nrm((DEPTH, S5_W, S5_W), S5_W ** -0.5),
        's5_b_glu': nrm((DEPTH, S5_W), 0.01),
        'hg_lb': nrm((DEPTH, HG_W)),
        'hg_norm': 1.0 + nrm((DEPTH, HG_DV), 0.01),
        'na_rpb': nrm((DEPTH, NA_H, 2 * NA_KH - 1, 2 * NA_KW - 1), 0.1),
        'w_mlp1': nrm((DEPTH, D_MODEL, D_FF), D_MODEL ** -0.5),
        'w_mlp2': nrm((DEPTH, D_FF, D_MODEL), D_FF ** -0.5),
        'norm_final': 1.0 + nrm((D_MODEL,), 0.01),
    }


def reference(x_prompt, x_sample, cache_k, cache_v, state_s5, state_hgrn, c, c_ctx,
              w_ada, b_ada, norm_mix, norm_mlp, w_in, w_out,
              s5_a_re, s5_a_im, s5_b_re, s5_b_im, s5_c_re, s5_c_im, s5_log_dt, s5_d, s5_w_glu, s5_b_glu,
              hg_lb, hg_norm, na_rpb, w_mlp1, w_mlp2, norm_final):
    P = dict(w_ada=w_ada, b_ada=b_ada, norm_mix=norm_mix, norm_mlp=norm_mlp, w_in=w_in, w_out=w_out,
             s5_a_re=s5_a_re, s5_a_im=s5_a_im, s5_b_re=s5_b_re, s5_b_im=s5_b_im,
             s5_c_re=s5_c_re, s5_c_im=s5_c_im, s5_log_dt=s5_log_dt, s5_d=s5_d,
             s5_w_glu=s5_w_glu, s5_b_glu=s5_b_glu, hg_lb=hg_lb, hg_norm=hg_norm,
             w_mlp1=w_mlp1, w_mlp2=w_mlp2)
    Bp = x_prompt.shape[0]
    s5_zero = jnp.zeros((Bp, 2, S5_G, S5_P, 2), jnp.float32)
    hg_zero = jnp.zeros((Bp, 2, HG_H, HG_DK, HG_DV), jnp.float32)
    xp = x_prompt
    ks, vs, s5s, hgs = [], [], [], []
    for l in range(DEPTH):
        xp, k, v, s5f, hgf = _layer(xp, _ada(c_ctx, l, P), l, P, s5_zero, hg_zero, ctx_attention)
        ks.append(k)
        vs.append(v)
        s5s.append(s5f)
        hgs.append(hgf)
    xs = x_sample
    for l in range(DEPTH):
        na_fn = functools.partial(na_latent, k_ctx=cache_k[:, l], v_ctx=cache_v[:, l], rpb=na_rpb[l])
        xs, _, _, _, _ = _layer(xs, _ada(c, l, P)[:, None, :], l, P, state_s5[:, l], state_hgrn[:, l], na_fn)
    y_prompt = rms_norm(xp, norm_final)
    y_sample = rms_norm(xs, norm_final)
    new_cache_k = jnp.stack(ks, axis=1)
    new_cache_v = jnp.stack(vs, axis=1)
    new_state_s5 = jnp.stack(s5s, axis=1)
    new_state_hgrn = jnp.stack(hgs, axis=1)
    return (y_prompt, y_sample, new_cache_k, new_cache_v, new_state_s5, new_state_hgrn)
```

```cpp
#include <hip/hip_runtime.h>
#include <hip/hip_cooperative_groups.h>
#include <cstdio>
#include <cstdint>
namespace cg = cooperative_groups;

#ifndef ONE_LAUNCH
#define ONE_LAUNCH 0
#endif

typedef unsigned short bf16_t;
typedef short bf16x8 __attribute__((ext_vector_type(8)));
typedef float f32x4 __attribute__((ext_vector_type(4)));
typedef unsigned u32x4 __attribute__((ext_vector_type(4)));
typedef unsigned u32x2 __attribute__((ext_vector_type(2)));

#define NTOK 6144
#define NCTX 4096
#define NPHASE 23

struct Params {
  const float *x_prompt, *x_sample, *cache_k, *cache_v, *state_s5, *state_hgrn, *c, *c_ctx;
  const float *w_ada, *b_ada, *norm_mix, *norm_mlp, *w_in, *w_out;
  const float *s5_a_re, *s5_a_im, *s5_b_re, *s5_b_im, *s5_c_re, *s5_c_im, *s5_log_dt, *s5_d, *s5_w_glu, *s5_b_glu;
  const float *hg_lb, *hg_norm, *na_rpb, *w_mlp1, *w_mlp2, *norm_final;
  float* out;
  bf16_t *wt_in, *wt_out, *wt_m1, *wt_m2, *wt_glu;
  float *adap, *mod, *z;
  bf16_t *h, *mix, *hid, *xg;
  float2 *apow, *bbar;
  float* ktab;
  bf16_t *atab, *wtab, *bts5;
  float* E;
  float *kv, *gdec, *sst;
};

#define OUT_CK 6291456
#define OUT_CV 10485760
#define OUT_S5 14680064
#define OUT_HG 14811136

__device__ __forceinline__ bf16_t f2bf(float f) {
  unsigned u = __float_as_uint(f);
  u += 0x7fffu + ((u >> 16) & 1u);
  return (bf16_t)(u >> 16);
}
__device__ __forceinline__ unsigned pack2(float a, float b) { return (unsigned)f2bf(a) | ((unsigned)f2bf(b) << 16); }
__device__ __forceinline__ float bf2f(bf16_t b) { return __uint_as_float(((unsigned)b) << 16); }
__device__ __forceinline__ float sigmoid_(float x) { return 1.f / (1.f + __expf(-x)); }
__device__ __forceinline__ float silu_(float x) { return x * sigmoid_(x); }
__device__ __forceinline__ float gelu_tanh(float y) {
  float t = 0.7978845608028654f * (y + 0.044715f * y * y * y);
  float th = 1.f - 2.f / (__expf(2.f * t) + 1.f);
  return 0.5f * y * (1.f + th);
}
__device__ __forceinline__ float wave_sum(float v) {
#pragma unroll
  for (int o = 32; o > 0; o >>= 1) v += __shfl_xor(v, o);
  return v;
}
__device__ __forceinline__ int variant_of(int n) { return n < NCTX ? 0 : 1 + ((n - NCTX) >> 10); }
__device__ __forceinline__ float lbv(const Params& P, int l, int c) {
  if (l == 0) return 0.f;
  float x0 = P.hg_lb[c], x1 = P.hg_lb[256 + c];
  return 1.f / (1.f + __expf(x0 - x1));
}

template <class Epi>
__device__ __forceinline__ void gemm_tile(const bf16_t* __restrict__ A, int lda, const bf16_t* __restrict__ B, int ldb, int K,
                                          char* lds, Epi epi) {
  const int tid = threadIdx.x, lane = tid & 63, w = tid >> 6, wr = w >> 1, wc = w & 1, fr = lane & 15, fq = lane >> 4;
  char* As = lds;
  char* Bs = lds + 16384;
  f32x4 acc[4][4];
#pragma unroll
  for (int i = 0; i < 4; ++i)
#pragma unroll
    for (int j = 0; j < 4; ++j) acc[i][j] = (f32x4){0.f, 0.f, 0.f, 0.f};
  u32x4 ra[4], rb[4];
  int loff[4];
  const bf16_t* gA[4];
  const bf16_t* gB[4];
#pragma unroll
  for (int i = 0; i < 4; ++i) {
    const int c = tid + 256 * i, row = c >> 3, ch = c & 7;
    loff[i] = row * 128 + ((ch ^ ((row >> 1) & 7)) << 4);
    gA[i] = A + (size_t)row * lda + ch * 8;
    gB[i] = B + (size_t)row * ldb + ch * 8;
  }
#pragma unroll
  for (int i = 0; i < 4; ++i) { ra[i] = *(const u32x4*)(gA[i]); rb[i] = *(const u32x4*)(gB[i]); }
  const int nk = K >> 6;
  for (int kt = 0; kt < nk; ++kt) {
    __syncthreads();
#pragma unroll
    for (int i = 0; i < 4; ++i) { *(u32x4*)(As + loff[i]) = ra[i]; *(u32x4*)(Bs + loff[i]) = rb[i]; }
    __syncthreads();
    if (kt + 1 < nk) {
      const int k0 = (kt + 1) << 6;
#pragma unroll
      for (int i = 0; i < 4; ++i) { ra[i] = *(const u32x4*)(gA[i] + k0); rb[i] = *(const u32x4*)(gB[i] + k0); }
    }
#pragma unroll
    for (int ks = 0; ks < 2; ++ks) {
      bf16x8 af[4], bfr[4];
#pragma unroll
      for (int mi = 0; mi < 4; ++mi) {
        const int row = wr * 64 + mi * 16 + fr;
        af[mi] = *(const bf16x8*)(As + row * 128 + (((ks * 4 + fq) ^ ((row >> 1) & 7)) << 4));
      }
#pragma unroll
      for (int ni = 0; ni < 4; ++ni) {
        const int row = wc * 64 + ni * 16 + fr;
        bfr[ni] = *(const bf16x8*)(Bs + row * 128 + (((ks * 4 + fq) ^ ((row >> 1) & 7)) << 4));
      }
#pragma unroll
      for (int mi = 0; mi < 4; ++mi)
#pragma unroll
        for (int ni = 0; ni < 4; ++ni)
          acc[mi][ni] = __builtin_amdgcn_mfma_f32_16x16x32_bf16(bfr[ni], af[mi], acc[mi][ni], 0, 0, 0);
    }
  }
#pragma unroll
  for (int mi = 0; mi < 4; ++mi)
#pragma unroll
    for (int ni = 0; ni < 4; ++ni) epi(wr * 64 + mi * 16 + fr, wc * 64 + ni * 16 + fq * 4, acc[mi][ni]);
}

__device__ void transpose_tile(const float* __restrict__ src, bf16_t* __restrict__ dst, int K, int N, int t, char* lds) {
  float* T = (float*)lds;
  const int tid = threadIdx.x;
  const int ntn = N >> 6, kt = t / ntn, nt = t % ntn;
  __syncthreads();
#pragma unroll
  for (int i = 0; i < 4; ++i) {
    const int idx = tid + 256 * i, kr = idx >> 4, n4 = idx & 15;
    const float4 v = *(const float4*)(src + (size_t)(kt * 64 + kr) * N + nt * 64 + n4 * 4);
    T[kr * 65 + n4 * 4 + 0] = v.x; T[kr * 65 + n4 * 4 + 1] = v.y; T[kr * 65 + n4 * 4 + 2] = v.z; T[kr * 65 + n4 * 4 + 3] = v.w;
  }
  __syncthreads();
#pragma unroll
  for (int i = 0; i < 2; ++i) {
    const int idx = tid + 256 * i, n = idx >> 3, kc = idx & 7;
    uint4 o;
    o.x = pack2(T[(kc * 8 + 0) * 65 + n], T[(kc * 8 + 1) * 65 + n]);
    o.y = pack2(T[(kc * 8 + 2) * 65 + n], T[(kc * 8 + 3) * 65 + n]);
    o.z = pack2(T[(kc * 8 + 4) * 65 + n], T[(kc * 8 + 5) * 65 + n]);
    o.w = pack2(T[(kc * 8 + 6) * 65 + n], T[(kc * 8 + 7) * 65 + n]);
    *(uint4*)(dst + (size_t)(nt * 64 + n) * K + kt * 64 + kc * 8) = o;
  }
}

__device__ void ada_unit(const Params& P, int u, char* lds) {
  float* sv = (float*)lds;
  const int tid = threadIdx.x;
  const int l = u / 384, r = u % 384, jb = r / 16, ks = r % 16;
  __syncthreads();
  if (tid < 192) {
    const int v = tid >> 6, k = ks * 64 + (tid & 63);
    const float cv = (v == 0) ? P.c_ctx[k] : P.c[(v - 1) * 1024 + k];
    sv[tid] = silu_(cv);
  }
  __syncthreads();
  const int j = jb * 256 + tid;
  const float* wp = P.w_ada + ((size_t)l * 1024 + ks * 64) * 6144 + j;
  float a0 = 0.f, a1 = 0.f, a2 = 0.f;
#pragma unroll 8
  for (int k = 0; k < 64; ++k) {
    const float wv = wp[(size_t)k * 6144];
    a0 += sv[k] * wv; a1 += sv[64 + k] * wv; a2 += sv[128 + k] * wv;
  }
  float* ap = P.adap + ((size_t)(l * 16 + ks) * 3) * 6144 + j;
  ap[0] = a0; ap[6144] = a1; ap[2 * 6144] = a2;
}

__device__ void s5pre_unit(const Params& P, int u, char* lds) {
  float2* apw = (float2*)lds;
  float2* bb = apw + 64 * 33;
  float2* cc = bb + 64 * 16;
  const int tid = threadIdx.x;
  const int ldg = u;
  __syncthreads();
  {
    const int p = tid & 63, part = tid >> 6;
    const float are = P.s5_a_re[ldg * 64 + p], aim = P.s5_a_im[ldg * 64 + p];
    const float dt = expf(P.s5_log_dt[ldg]);
    for (int tau = part; tau <= 32; tau += 4) {
      const float mag = expf((float)tau * are * dt);
      const float ang = (float)tau * aim * dt;
      float sn, cs;
      sincosf(ang, &sn, &cs);
      const float2 v = make_float2(mag * cs, mag * sn);
      apw[p * 33 + tau] = v;
      P.apow[((size_t)ldg * 64 + p) * 33 + tau] = v;
    }
  }
  __syncthreads();
  for (int e = tid; e < 1024; e += 256) {
    const int p = e >> 4, hh = e & 15;
    const float are = P.s5_a_re[ldg * 64 + p], aim = P.s5_a_im[ldg * 64 + p];
    const float2 ab = apw[p * 33 + 1];
    const float nr = ab.x - 1.f, ni = ab.y, den = are * are + aim * aim;
    const float cr = (nr * are + ni * aim) / den, ci = (ni * are - nr * aim) / den;
    const float br = P.s5_b_re[((size_t)ldg * 64 + p) * 16 + hh], bi = P.s5_b_im[((size_t)ldg * 64 + p) * 16 + hh];
    const float2 v = make_float2(cr * br - ci * bi, cr * bi + ci * br);
    bb[p * 16 + hh] = v;
    P.bbar[((size_t)ldg * 64 + p) * 16 + hh] = v;
    const int h2 = e >> 6, p2 = e & 63;
    cc[h2 * 64 + p2] = make_float2(P.s5_c_re[((size_t)ldg * 16 + h2) * 64 + p2], P.s5_c_im[((size_t)ldg * 16 + h2) * 64 + p2]);
  }
  __syncthreads();
  for (int e = tid; e < 8192; e += 256) {
    const int tau = e >> 8, hh = (e >> 4) & 15, h2 = e & 15;
    float s = 0.f;
    for (int p = 0; p < 64; ++p) {
      const float2 c = cc[hh * 64 + p], a = apw[p * 33 + tau], b = bb[p * 16 + h2];
      const float tr = a.x * b.x - a.y * b.y, ti = a.x * b.y + a.y * b.x;
      s += c.x * tr - c.y * ti;
    }
    P.ktab[(size_t)ldg * 8192 + e] = s;
  }
}

__device__ void phase0a(const Params& P, char* lds) {
  const int tid = threadIdx.x;
  const int U_S5 = 64, U_ADA = 768, U_M1 = 2048, U_M2 = 2048, U_IN = 1536, U_OUT = 512, U_GLU = 32, U_X = 768;
  const int total = U_S5 + U_ADA + U_M1 + U_M2 + U_IN + U_OUT + U_GLU + U_X;
  for (int u0 = blockIdx.x; u0 < total; u0 += gridDim.x) {
    int u = u0;
    if (u < U_S5) { s5pre_unit(P, u, lds); continue; }
    u -= U_S5;
    if (u < U_ADA) { ada_unit(P, u, lds); continue; }
    u -= U_ADA;
    if (u < U_M1) { const int l = u >> 10; transpose_tile(P.w_mlp1 + (size_t)l * 1024 * 4096, P.wt_m1 + (size_t)l * 4096 * 1024, 1024, 4096, u & 1023, lds); continue; }
    u -= U_M1;
    if (u < U_M2) { const int l = u >> 10; transpose_tile(P.w_mlp2 + (size_t)l * 4096 * 1024, P.wt_m2 + (size_t)l * 1024 * 4096, 4096, 1024, u & 1023, lds); continue; }
    u -= U_M2;
    if (u < U_IN) { const int l = u / 768; transpose_tile(P.w_in + (size_t)l * 1024 * 3072, P.wt_in + (size_t)l * 3072 * 1024, 1024, 3072, u % 768, lds); continue; }
    u -= U_IN;
    if (u < U_OUT) { const int l = u >> 8; transpose_tile(P.w_out + (size_t)l * 1024 * 1024, P.wt_out + (size_t)l * 1024 * 1024, 1024, 1024, u & 255, lds); continue; }
    u -= U_OUT;
    if (u < U_GLU) { const int l = u >> 4; transpose_tile(P.s5_w_glu + (size_t)l * 256 * 256, P.wt_glu + (size_t)l * 256 * 256, 256, 256, u & 15, lds); continue; }
    u -= U_GLU;
    {
      const size_t base = (size_t)u * 8192;
#pragma unroll
      for (int i = 0; i < 8; ++i) {
        const size_t e = base + (size_t)(tid + 256 * i) * 4;
        const float4 v = (e < (size_t)NCTX * 1024) ? *(const float4*)(P.x_prompt + e) : *(const float4*)(P.x_sample + (e - (size_t)NCTX * 1024));
        *(float4*)(P.out + e) = v;
      }
    }
  }
}

__device__ void phase0b(const Params& P) {
  const size_t gtid = (size_t)blockIdx.x * 256 + threadIdx.x, gsz = (size_t)gridDim.x * 256;
  for (size_t e = gtid; e < 2 * 3 * 6144; e += gsz) {
    const int l = (int)(e / (3 * 6144)), r = (int)(e % (3 * 6144)), j = r % 6144;
    float s = P.b_ada[l * 6144 + j];
    for (int ks = 0; ks < 16; ++ks) s += P.adap[((size_t)(l * 16 + ks) * 3) * 6144 + r];
    P.mod[e] = s;
  }
  for (size_t e2 = gtid; e2 < (size_t)2 * 16 * 512 * 384; e2 += gsz) {
    const int k0 = (int)(e2 % 384) * 2;
    const int m = (int)((e2 / 384) % 512);
    const int lg = (int)(e2 / (384 * 512));
    const int l = lg >> 4, g = lg & 15, i = m >> 4, hh = m & 15;
    const int ldg0 = (l * 2 + 0) * 16 + g, ldg1 = (l * 2 + 1) * 16 + g;
    float v[2];
    if (k0 < 512) {
#pragma unroll
      for (int q = 0; q < 2; ++q) {
        const int k = k0 + q, j = k >> 4, h2 = k & 15;
        float s = 0.f;
        if (j <= i) s += P.ktab[(size_t)ldg0 * 8192 + (i - j) * 256 + hh * 16 + h2];
        if (j >= i) s += P.ktab[(size_t)ldg1 * 8192 + (j - i) * 256 + hh * 16 + h2];
        if (j == i && h2 == hh) s += P.s5_d[l * 256 + g * 16 + hh];
        v[q] = s;
      }
    } else {
      const int d = (k0 >= 640) ? 1 : 0;
      const int p = ((k0 - 512) & 127) >> 1;
      const int ldg = d ? ldg1 : ldg0;
      const int pw = d ? (32 - i) : (i + 1);
      const float2 a = P.apow[((size_t)ldg * 64 + p) * 33 + pw];
      const float cr = P.s5_c_re[((size_t)ldg * 16 + hh) * 64 + p], ci = P.s5_c_im[((size_t)ldg * 16 + hh) * 64 + p];
      v[0] = cr * a.x - ci * a.y;
      v[1] = -(cr * a.y + ci * a.x);
    }
    *(unsigned*)(P.atab + (((size_t)lg * 512 + m) * 768 + k0)) = pack2(v[0], v[1]);
  }
  for (size_t e2 = gtid; e2 < (size_t)2 * 16 * 256 * 256; e2 += gsz) {
    const int k0 = (int)(e2 % 256) * 2;
    const int row = (int)((e2 / 256) % 256);
    const int lg = (int)(e2 / (256 * 256));
    const int l = lg >> 4, g = lg & 15;
    const int d = row >> 7, p = (row & 127) >> 1, ri = row & 1;
    const int ldg = (l * 2 + d) * 16 + g;
    const int j = k0 >> 4, h2 = k0 & 15;
    const int pw = d ? j : (31 - j);
    const float2 a = P.apow[((size_t)ldg * 64 + p) * 33 + pw];
    float v[2];
#pragma unroll
    for (int q = 0; q < 2; ++q) {
      const float2 b = P.bbar[((size_t)ldg * 64 + p) * 16 + h2 + q];
      v[q] = ri ? (a.x * b.y + a.y * b.x) : (a.x * b.x - a.y * b.y);
    }
    *(unsigned*)(P.wtab + (((size_t)lg * 256 + row) * 512 + k0)) = pack2(v[0], v[1]);
  }
}

__device__ void normmod_phase(const Params& P, int l, int which) {
  const int lane = threadIdx.x & 63, w = threadIdx.x >> 6;
  const float* gam = (which == 0 ? P.norm_mix : P.norm_mlp) + l * 1024;
  for (int n = blockIdx.x * 4 + w; n < NTOK; n += gridDim.x * 4) {
    const float* xr = P.out + (size_t)n * 1024;
    const float* md = P.mod + ((size_t)(l * 3 + variant_of(n))) * 6144 + (which == 0 ? 0 : 3072);
    float4 v[4];
    float ss = 0.f;
#pragma unroll
    for (int i = 0; i < 4; ++i) {
      v[i] = *(const float4*)(xr + lane * 4 + 256 * i);
      ss += v[i].x * v[i].x + v[i].y * v[i].y + v[i].z * v[i].z + v[i].w * v[i].w;
    }
    ss = wave_sum(ss);
    const float rstd = rsqrtf(ss * (1.f / 1024.f) + 1e-6f);
#pragma unroll
    for (int i = 0; i < 4; ++i) {
      const int k = lane * 4 + 256 * i;
      const float4 g = *(const float4*)(gam + k), sh = *(const float4*)(md + k), sc = *(const float4*)(md + 1024 + k);
      const float o0 = v[i].x * rstd * g.x * (1.f + sc.x) + sh.x;
      const float o1 = v[i].y * rstd * g.y * (1.f + sc.y) + sh.y;
      const float o2 = v[i].z * rstd * g.z * (1.f + sc.z) + sh.z;
      const float o3 = v[i].w * rstd * g.w * (1.f + sc.w) + sh.w;
      uint2 o; o.x = pack2(o0, o1); o.y = pack2(o2, o3);
      *(uint2*)(P.h + (size_t)n * 1024 + k) = o;
    }
  }
}

__device__ void final_phase(const Params& P) {
  const int lane = threadIdx.x & 63, w = threadIdx.x >> 6;
  for (int n = blockIdx.x * 4 + w; n < NTOK; n += gridDim.x * 4) {
    float* xr = P.out + (size_t)n * 1024;
    float4 v[4];
    float ss = 0.f;
#pragma unroll
    for (int i = 0; i < 4; ++i) {
      v[i] = *(const float4*)(xr + lane * 4 + 256 * i);
      ss += v[i].x * v[i].x + v[i].y * v[i].y + v[i].z * v[i].z + v[i].w * v[i].w;
    }
    ss = wave_sum(ss);
    const float rstd = rsqrtf(ss * (1.f / 1024.f) + 1e-6f);
#pragma unroll
    for (int i = 0; i < 4; ++i) {
      const int k = lane * 4 + 256 * i;
      const float4 g = *(const float4*)(P.norm_final + k);
      float4 o; o.x = v[i].x * rstd * g.x; o.y = v[i].y * rstd * g.y; o.z = v[i].z * rstd * g.z; o.w = v[i].w * rstd * g.w;
      *(float4*)(xr + k) = o;
    }
  }
}

__device__ void win_phase(const Params& P, int l, char* lds) {
  for (int u = blockIdx.x; u < 48 * 24; u += gridDim.x) {
    const int mt = u / 24, nt = u % 24, m0 = mt * 128, n0 = nt * 128;
    gemm_tile(P.h + (size_t)m0 * 1024, 1024, P.wt_in + ((size_t)l * 3072 + n0) * 1024, 1024, 1024, lds,
      [&](int rl, int cl, f32x4 v) {
        const int n = m0 + rl, c = n0 + cl;
        *(f32x4*)(P.z + (size_t)n * 3072 + c) = v;
        if (c < 256) {
          const int g = c >> 4;
          uint2 o; o.x = pack2(v[0], v[1]); o.y = pack2(v[2], v[3]);
          *(uint2*)(P.bts5 + ((size_t)(g * 256 + (n >> 5)) * 768 + (n & 31) * 16 + (c & 15))) = o;
        }
        if (c >= 2048 && n < NCTX) {
          const int b = n >> 8, t = n & 255;
          float* dst = P.out + (c < 2560 ? OUT_CK : OUT_CV) + ((size_t)((b * 2 + l) * 256 + t)) * 512 + ((c - 2048) & 511);
          *(f32x4*)dst = v;
        }
      });
  }
}

__device__ void wout_phase(const Params& P, int l, char* lds) {
  for (int u = blockIdx.x; u < 48 * 8; u += gridDim.x) {
    const int mt = u / 8, nt = u % 8, m0 = mt * 128, n0 = nt * 128;
    gemm_tile(P.mix + (size_t)m0 * 1024, 1024, P.wt_out + ((size_t)l * 1024 + n0) * 1024, 1024, 1024, lds,
      [&](int rl, int cl, f32x4 v) {
        const int n = m0 + rl, c = n0 + cl;
        const f32x4 g = *(const f32x4*)(P.mod + ((size_t)(l * 3 + variant_of(n))) * 6144 + 2048 + c);
        f32x4* xp = (f32x4*)(P.out + (size_t)n * 1024 + c);
        *xp = *xp + g * v;
      });
  }
}

__device__ void mlp1_phase(const Params& P, int l, char* lds) {
  for (int u = blockIdx.x; u < 48 * 32; u += gridDim.x) {
    const int mt = u / 32, nt = u % 32, m0 = mt * 128, n0 = nt * 128;
    gemm_tile(P.h + (size_t)m0 * 1024, 1024, P.wt_m1 + ((size_t)l * 4096 + n0) * 1024, 1024, 1024, lds,
      [&](int rl, int cl, f32x4 v) {
        const int n = m0 + rl, c = n0 + cl;
        float r0 = fmaxf(v[0], 0.f), r1 = fmaxf(v[1], 0.f), r2 = fmaxf(v[2], 0.f), r3 = fmaxf(v[3], 0.f);
        uint2 o; o.x = pack2(r0 * r0, r1 * r1); o.y = pack2(r2 * r2, r3 * r3);
        *(uint2*)(P.hid + (size_t)n * 4096 + c) = o;
      });
  }
}

__device__ void mlp2_phase(const Params& P, int l, char* lds) {
  for (int u = blockIdx.x; u < 48 * 8; u += gridDim.x) {
    const int mt = u / 8, nt = u % 8, m0 = mt * 128, n0 = nt * 128;
    gemm_tile(P.hid + (size_t)m0 * 4096, 4096, P.wt_m2 + ((size_t)l * 1024 + n0) * 4096, 4096, 4096, lds,
      [&](int rl, int cl, f32x4 v) {
        const int n = m0 + rl, c = n0 + cl;
        const f32x4 g = *(const f32x4*)(P.mod + ((size_t)(l * 3 + variant_of(n))) * 6144 + 5120 + c);
        f32x4* xp = (f32x4*)(P.out + (size_t)n * 1024 + c);
        *xp = *xp + g * v;
      });
  }
}

__device__ void s5e_unit(const Params& P, int l, int u, char* lds) {
  const int g = u >> 2, mt = (u >> 1) & 1, nt = u & 1;
  gemm_tile(P.wtab + ((size_t)(l * 16 + g) * 256 + mt * 128) * 512, 512, P.bts5 + ((size_t)g * 256 + nt * 128) * 768, 768, 512, lds,
    [&](int rl, int cl, f32x4 v) {
      const int row = mt * 128 + rl, col = nt * 128 + cl;
      if (col < 192) *(f32x4*)(P.E + ((size_t)(g * 256 + row)) * 192 + col) = v;
    });
}

__device__ void s5y_unit(const Params& P, int l, int u, char* lds) {
  const int g = u >> 3, mt = (u >> 1) & 3, nt = u & 1;
  gemm_tile(P.atab + ((size_t)(l * 16 + g) * 512 + mt * 128) * 768, 768, P.bts5 + ((size_t)g * 256 + nt * 128) * 768, 768, 768, lds,
    [&](int rl, int cl, f32x4 v) {
      const int m = mt * 128 + rl, col = nt * 128 + cl;
      if (col < 192) {
        const int i = m >> 4, hh = m & 15;
#pragma unroll
        for (int q = 0; q < 4; ++q) {
          const int n = (col + q) * 32 + i;
          P.xg[(size_t)n * 256 + g * 16 + hh] = f2bf(gelu_tanh(v[q]));
        }
      }
    });
}

__device__ void glu_phase(const Params& P, int l, char* lds) {
  for (int u = blockIdx.x; u < 96; u += gridDim.x) {
    const int mt = u >> 1, nt = u & 1, m0 = mt * 128, n0 = nt * 128;
    gemm_tile(P.xg + (size_t)m0 * 256, 256, P.wt_glu + ((size_t)l * 256 + n0) * 256, 256, 256, lds,
      [&](int rl, int cl, f32x4 v) {
        const int n = m0 + rl, c = n0 + cl;
        const uint2 xv = *(const uint2*)(P.xg + (size_t)n * 256 + c);
        const f32x4 bg = *(const f32x4*)(P.s5_b_glu + l * 256 + c);
        const float x0 = bf2f((bf16_t)(xv.x & 0xffff)), x1 = bf2f((bf16_t)(xv.x >> 16)), x2 = bf2f((bf16_t)(xv.y & 0xffff)), x3 = bf2f((bf16_t)(xv.y >> 16));
        uint2 o;
        o.x = pack2(x0 * sigmoid_(v[0] + bg[0]), x1 * sigmoid_(v[1] + bg[1]));
        o.y = pack2(x2 * sigmoid_(v[2] + bg[2]), x3 * sigmoid_(v[3] + bg[3]));
        *(uint2*)(P.mix + (size_t)n * 1024 + c) = o;
      });
  }
}

__device__ void attn_unit(const Params& P, int l, int unit, char* lds) {
  char* Ks = lds;
  bf16_t* Vt = (bf16_t*)(lds + 8192);
  float* rpbS = (float*)(lds + 8192 + 64 * 68 * 2);
  const int tid = threadIdx.x, lane = tid & 63, w = tid >> 6, fr = lane & 15, fq = lane >> 4;
  const bool lat = unit < 256;
  int b, h, qrow0, ntiles, r = 0, r_start = 0;
  if (lat) { b = unit >> 7; h = (unit >> 4) & 7; r = unit & 15; qrow0 = NCTX + b * 1024 + r * 64; ntiles = 16; r_start = min(max(r - 4, 0), 8); }
  else { const int v = unit - 256; b = v >> 5; h = (v >> 2) & 7; qrow0 = b * 256 + (v & 3) * 64; ntiles = 4; }
  __syncthreads();
  if (lat) for (int i = tid; i < 465; i += 256) rpbS[i] = P.na_rpb[(size_t)((l * 8 + h) * 15) * 31 + i];
  bf16x8 qf[2];
  {
    const float* zq = P.z + (size_t)(qrow0 + w * 16 + fr) * 3072 + 1536 + h * 64;
#pragma unroll
    for (int ks = 0; ks < 2; ++ks) {
      const float4 a = *(const float4*)(zq + ks * 32 + fq * 8), c = *(const float4*)(zq + ks * 32 + fq * 8 + 4);
      qf[ks][0] = (short)f2bf(a.x * 0.125f); qf[ks][1] = (short)f2bf(a.y * 0.125f); qf[ks][2] = (short)f2bf(a.z * 0.125f); qf[ks][3] = (short)f2bf(a.w * 0.125f);
      qf[ks][4] = (short)f2bf(c.x * 0.125f); qf[ks][5] = (short)f2bf(c.y * 0.125f); qf[ks][6] = (short)f2bf(c.z * 0.125f); qf[ks][7] = (short)f2bf(c.w * 0.125f);
    }
  }
  float m = -INFINITY, lsum = 0.f;
  f32x4 o[4];
#pragma unroll
  for (int i = 0; i < 4; ++i) o[i] = (f32x4){0.f, 0.f, 0.f, 0.f};
  f32x4 kr[4], vr[4];
#define ATT_LOAD_TILE(t_)                                                                                              \
  {                                                                                                                    \
    const int tt = (t_);                                                                                               \
    const float* kp; const float* vp; int ld;                                                                          \
    if (!lat) { kp = P.z + (size_t)(b * 256 + tt * 64) * 3072 + 2048 + h * 64; vp = kp + 512; ld = 3072; }             \
    else if (tt < 8) { const size_t base = ((size_t)((b * 2 + l) * 512 + tt * 64)) * 512 + h * 64; kp = P.cache_k + base; vp = P.cache_v + base; ld = 512; } \
    else { kp = P.z + (size_t)(NCTX + b * 1024 + (r_start + tt - 8) * 64) * 3072 + 2048 + h * 64; vp = kp + 512; ld = 3072; } \
    _Pragma("unroll") for (int i = 0; i < 4; ++i) {                                                                    \
      const int idx = tid + 256 * i, key = idx >> 4, d4 = idx & 15;                                                    \
      kr[i] = *(const f32x4*)(kp + (size_t)key * ld + d4 * 4);                                                         \
      vr[i] = *(const f32x4*)(vp + (size_t)key * ld + d4 * 4);                                                         \
    }                                                                                                                  \
  }
  ATT_LOAD_TILE(0);
  for (int t = 0; t < ntiles; ++t) {
    __syncthreads();
#pragma unroll
    for (int i = 0; i < 4; ++i) {
      const int idx = tid + 256 * i, key = idx >> 4, d4 = idx & 15;
      u32x2 kk; kk.x = pack2(kr[i][0], kr[i][1]); kk.y = pack2(kr[i][2], kr[i][3]);
      *(u32x2*)(Ks + key * 128 + ((((d4 >> 1) ^ ((key >> 1) & 7)) << 4) | ((d4 & 1) << 3))) = kk;
      Vt[(d4 * 4 + 0) * 68 + key] = f2bf(vr[i][0]);
      Vt[(d4 * 4 + 1) * 68 + key] = f2bf(vr[i][1]);
      Vt[(d4 * 4 + 2) * 68 + key] = f2bf(vr[i][2]);
      Vt[(d4 * 4 + 3) * 68 + key] = f2bf(vr[i][3]);
    }
    __syncthreads();
    if (t + 1 < ntiles) ATT_LOAD_TILE(t + 1);
    f32x4 s[4];
#pragma unroll
    for (int kt = 0; kt < 4; ++kt) {
      s[kt] = (f32x4){0.f, 0.f, 0.f, 0.f};
      const int key = kt * 16 + fr;
#pragma unroll
      for (int ks = 0; ks < 2; ++ks) {
        const bf16x8 a = *(const bf16x8*)(Ks + key * 128 + (((ks * 4 + fq) ^ ((key >> 1) & 7)) << 4));
        s[kt] = __builtin_amdgcn_mfma_f32_16x16x32_bf16(a, qf[ks], s[kt], 0, 0, 0);
      }
    }
    if (lat && t >= 8) {
      const int dr = r_start + (t - 8) - r + 7;
      const int qc = w * 16 + fr;
      const int cs = min(max(qc - 8, 0), 48);
#pragma unroll
      for (int kt = 0; kt < 4; ++kt)
#pragma unroll
        for (int rr = 0; rr < 4; ++rr) {
          const int kc = kt * 16 + fq * 4 + rr;
          const bool in = (kc >= cs) && (kc < cs + 16);
          const int dc = min(max(kc - qc + 15, 0), 30);
          s[kt][rr] = in ? s[kt][rr] + rpbS[dr * 31 + dc] : -1e30f;
        }
    }
    float mx = -INFINITY;
#pragma unroll
    for (int kt = 0; kt < 4; ++kt)
#pragma unroll
      for (int rr = 0; rr < 4; ++rr) mx = fmaxf(mx, s[kt][rr]);
    mx = fmaxf(mx, __shfl_xor(mx, 16));
    mx = fmaxf(mx, __shfl_xor(mx, 32));
    const float mn = fmaxf(m, mx);
    const float alpha = __expf(m - mn);
    float ps = 0.f;
#pragma unroll
    for (int kt = 0; kt < 4; ++kt)
#pragma unroll
      for (int rr = 0; rr < 4; ++rr) { s[kt][rr] = __expf(s[kt][rr] - mn); ps += s[kt][rr]; }
    ps += __shfl_xor(ps, 16);
    ps += __shfl_xor(ps, 32);
    lsum = lsum * alpha + ps;
    m = mn;
#pragma unroll
    for (int i = 0; i < 4; ++i) o[i] = o[i] * alpha;
#pragma unroll
    for (int c = 0; c < 2; ++c) {
      bf16x8 pb;
      pb[0] = (short)f2bf(s[2 * c][0]); pb[1] = (short)f2bf(s[2 * c][1]); pb[2] = (short)f2bf(s[2 * c][2]); pb[3] = (short)f2bf(s[2 * c][3]);
      pb[4] = (short)f2bf(s[2 * c + 1][0]); pb[5] = (short)f2bf(s[2 * c + 1][1]); pb[6] = (short)f2bf(s[2 * c + 1][2]); pb[7] = (short)f2bf(s[2 * c + 1][3]);
#pragma unroll
      for (int dt = 0; dt < 4; ++dt) {
        const int d = dt * 16 + fr;
        const u32x2 lo = *(const u32x2*)(Vt + d * 68 + (2 * c) * 16 + fq * 4);
        const u32x2 hi = *(const u32x2*)(Vt + d * 68 + (2 * c + 1) * 16 + fq * 4);
        const u32x4 avu = (u32x4){lo.x, lo.y, hi.x, hi.y};
        o[dt] = __builtin_amdgcn_mfma_f32_16x16x32_bf16(__builtin_bit_cast(bf16x8, avu), pb, o[dt], 0, 0, 0);
      }
    }
  }
  const float inv = 1.f / lsum;
  bf16_t* mp = P.mix + (size_t)(qrow0 + w * 16 + fr) * 1024 + 512 + h * 64 + fq * 4;
#pragma unroll
  for (int dt = 0; dt < 4; ++dt) {
    uint2 ov; ov.x = pack2(o[dt][0] * inv, o[dt][1] * inv); ov.y = pack2(o[dt][2] * inv, o[dt][3] * inv);
    *(uint2*)(mp + dt * 16) = ov;
  }
}

__device__ void hgrn_a_unit(const Params& P, int l, int unit, char* lds) {
  float* fS = (float*)lds;
  float* vS = fS + 4096;
  const int tid = threadIdx.x, dv = tid & 63, q4 = tid >> 6;
  const int mc = unit >> 3, h = (unit >> 1) & 3, d = unit & 1, n0 = mc * 64;
  const int zfcol = (d == 0 ? 512 : 768) + h * 64;
  __syncthreads();
#pragma unroll 4
  for (int e = 0; e < 16; ++e) {
    const int idx = tid + 256 * e, s = idx >> 6, ch = idx & 63;
    const float* zrow = P.z + (size_t)(n0 + s) * 3072;
    const float lb = lbv(P, l, h * 64 + ch);
    fS[idx] = lb + (1.f - lb) * sigmoid_(zrow[zfcol + ch]);
    vS[idx] = zrow[1024 + h * 64 + ch];
  }
  __syncthreads();
  float S[16];
#pragma unroll
  for (int j = 0; j < 16; ++j) S[j] = 0.f;
  for (int i = 0; i < 64; ++i) {
    const int s = d ? 63 - i : i;
    const float vv = vS[s * 64 + dv];
#pragma unroll
    for (int j = 0; j < 16; ++j) {
      const float fv = fS[s * 64 + q4 * 16 + j];
      S[j] = fv * S[j] + (1.f - fv) * vv;
    }
  }
#pragma unroll
  for (int j = 0; j < 16; ++j) P.kv[((size_t)unit * 64 + q4 * 16 + j) * 64 + dv] = S[j];
  if (tid < 64) {
    float g = 1.f;
    for (int s = 0; s < 64; ++s) g *= fS[s * 64 + tid];
    P.gdec[unit * 64 + tid] = g;
  }
}

__device__ void hgrn_b_unit(const Params& P, int l, int unit, char* lds) {
  float* fS = (float*)lds;
  float* qS = fS + 1024;
  float* vS = qS + 1024;
  float* opart = vS + 1024;
  float* osum = opart + 4096;
  const int tid = threadIdx.x, dv = tid & 63, q4 = tid >> 6;
  const int mc = unit >> 2, h = unit & 3, n0 = mc * 64;
  for (int d = 0; d < 2; ++d) {
    float S[16];
    const int su = (mc * 4 + h) * 2 + d;
#pragma unroll
    for (int j = 0; j < 16; ++j) S[j] = P.sst[((size_t)su * 64 + q4 * 16 + j) * 64 + dv];
    const int zfcol = (d == 0 ? 512 : 768) + h * 64;
    for (int sub = 0; sub < 4; ++sub) {
      __syncthreads();
#pragma unroll
      for (int e = 0; e < 4; ++e) {
        const int idx = tid + 256 * e, i = idx >> 6, ch = idx & 63, tl = sub * 16 + i, s = d ? 63 - tl : tl;
        const float* zrow = P.z + (size_t)(n0 + s) * 3072;
        const float lb = lbv(P, l, h * 64 + ch);
        fS[idx] = lb + (1.f - lb) * sigmoid_(zrow[zfcol + ch]);
        qS[idx] = silu_(zrow[256 + h * 64 + ch]);
        vS[idx] = zrow[1024 + h * 64 + ch];
      }
      __syncthreads();
      for (int i = 0; i < 16; ++i) {
        float po = 0.f;
        const float vv = vS[i * 64 + dv];
#pragma unroll
        for (int j = 0; j < 16; ++j) {
          const float fv = fS[i * 64 + q4 * 16 + j];
          S[j] = fv * S[j] + (1.f - fv) * vv;
          po += S[j] * qS[i * 64 + q4 * 16 + j];
        }
        opart[(q4 * 16 + i) * 64 + dv] = po;
      }
      __syncthreads();
#pragma unroll
      for (int e = 0; e < 4; ++e) {
        const int idx = tid + 256 * e, i = idx >> 6, dvv = idx & 63, tl = sub * 16 + i, s = d ? 63 - tl : tl;
        const float sum = opart[(0 * 16 + i) * 64 + dvv] + opart[(1 * 16 + i) * 64 + dvv] + opart[(2 * 16 + i) * 64 + dvv] + opart[(3 * 16 + i) * 64 + dvv];
        if (d == 0) osum[s * 64 + dvv] = sum; else osum[s * 64 + dvv] += sum;
      }
    }
  }
  __syncthreads();
  {
    const int w = tid >> 6, lane = tid & 63;
    const float gn = P.hg_norm[l * 64 + lane];
    for (int i = 0; i < 16; ++i) {
      const int s = w * 16 + i;
      const float val = osum[s * 64 + lane];
      const float ss = wave_sum(val * val);
      const float gate = P.z[(size_t)(n0 + s) * 3072 + 1280 + h * 64 + lane];
      const float y = val * rsqrtf(ss * (1.f / 64.f) + 1e-6f) * gn * silu_(gate);
      P.mix[(size_t)(n0 + s) * 1024 + 256 + h * 64 + lane] = f2bf(y);
    }
  }
  __syncthreads();
}

__device__ void carry_phase(const Params& P, int l) {
  const size_t gtid = (size_t)blockIdx.x * 256 + threadIdx.x, gsz = (size_t)gridDim.x * 256;
  for (size_t e = gtid; e < (size_t)18 * 4 * 2 * 4096; e += gsz) {
    const int dv = (int)(e & 63), dk = (int)((e >> 6) & 63), d = (int)((e >> 12) & 1), h = (int)((e >> 13) & 3), bb = (int)(e >> 15);
    int mcb, nc; float S;
    if (bb < 16) { mcb = bb * 4; nc = 4; S = 0.f; }
    else { mcb = 64 + (bb - 16) * 16; nc = 16; S = P.state_hgrn[((((size_t)((bb - 16) * 2 + l) * 2 + d) * 4 + h) * 64 + dk) * 64 + dv]; }
    for (int cc = 0; cc < nc; ++cc) {
      const int c = d ? nc - 1 - cc : cc;
      const size_t u = (size_t)((mcb + c) * 4 + h) * 2 + d;
      P.sst[(u * 64 + dk) * 64 + dv] = S;
      S = P.gdec[u * 64 + dk] * S + P.kv[(u * 64 + dk) * 64 + dv];
    }
    if (bb < 16) P.out[OUT_HG + ((((size_t)(bb * 2 + l) * 2 + d) * 4 + h) * 64 + dk) * 64 + dv] = S;
  }
  for (size_t e = gtid; e < (size_t)18 * 16 * 2 * 64; e += gsz) {
    const int p = (int)(e & 63), d = (int)((e >> 6) & 1), g = (int)((e >> 7) & 15), bb = (int)(e >> 11);
    const int ldg = (l * 2 + d) * 16 + g;
    int cb, nc; float sr, si;
    if (bb < 16) { cb = bb * 8; nc = 8; sr = 0.f; si = 0.f; }
    else {
      cb = 128 + (bb - 16) * 32; nc = 32;
      const float* sp = P.state_s5 + (((((size_t)((bb - 16) * 2 + l) * 2 + d) * 16 + g) * 64 + p) * 2);
      sr = sp[0]; si = sp[1];
    }
    const float2 aT = P.apow[((size_t)ldg * 64 + p) * 33 + 32];
    for (int cc = 0; cc < nc; ++cc) {
      const int c = d ? nc - 1 - cc : cc;
      *(unsigned*)(P.bts5 + ((size_t)(g * 256 + cb + c) * 768 + 512 + d * 128 + p * 2)) = pack2(sr, si);
      const float er = P.E[((size_t)(g * 256 + d * 128 + p * 2 + 0)) * 192 + cb + c];
      const float ei = P.E[((size_t)(g * 256 + d * 128 + p * 2 + 1)) * 192 + cb + c];
      const float nr = aT.x * sr - aT.y * si + er, ni = aT.x * si + aT.y * sr + ei;
      sr = nr; si = ni;
    }
    if (bb < 16) {
      const int ne = bb * 256 + (d ? 255 : 0);
      const float* ur = P.z + (size_t)ne * 3072 + g * 16;
      float fr_ = 0.f, fi_ = 0.f;
#pragma unroll
      for (int hh = 0; hh < 16; ++hh) {
        const float2 bv = P.bbar[((size_t)ldg * 64 + p) * 16 + hh];
        fr_ += ur[hh] * bv.x; fi_ += ur[hh] * bv.y;
      }
      float* op = P.out + OUT_S5 + (((((size_t)(bb * 2 + l) * 2 + d) * 16 + g) * 64 + p) * 2);
      op[0] = fr_; op[1] = fi_;
    }
  }
}

__device__ void mixa_phase(const Params& P, int l, char* lds) {
  for (int u = blockIdx.x; u < 768 + 768 + 64; u += gridDim.x) {
    if (u < 768) attn_unit(P, l, u, lds);
    else if (u < 1536) hgrn_a_unit(P, l, u - 768, lds);
    else s5e_unit(P, l, u - 1536, lds);
  }
}
__device__ void mixb_phase(const Params& P, int l, char* lds) {
  for (int u = blockIdx.x; u < 384 + 128; u += gridDim.x) {
    if (u < 384) hgrn_b_unit(P, l, u, lds);
    else s5y_unit(P, l, u - 384, lds);
  }
}

template <int S>
__device__ __forceinline__ void run_step(const Params& P, int l, char* lds) {
  if constexpr (S == 0) phase0a(P, lds);
  else if constexpr (S == 1) phase0b(P);
  else if constexpr (S == 2) normmod_phase(P, l, 0);
  else if constexpr (S == 3) win_phase(P, l, lds);
  else if constexpr (S == 4) mixa_phase(P, l, lds);
  else if constexpr (S == 5) carry_phase(P, l);
  else if constexpr (S == 6) mixb_phase(P, l, lds);
  else if constexpr (S == 7) glu_phase(P, l, lds);
  else if constexpr (S == 8) wout_phase(P, l, lds);
  else if constexpr (S == 9) normmod_phase(P, l, 1);
  else if constexpr (S == 10) mlp1_phase(P, l, lds);
  else if constexpr (S == 11) mlp2_phase(P, l, lds);
  else final_phase(P);
}

#if ONE_LAUNCH
__global__ void __launch_bounds__(256, 2) mega(Params P) {
  __shared__ __attribute__((aligned(16))) char lds[45056];
  cg::grid_group grid = cg::this_grid();
  run_step<0>(P, 0, lds); grid.sync();
  run_step<1>(P, 0, lds); grid.sync();
#pragma nounroll
  for (int l = 0; l < 2; ++l) {
    run_step<2>(P, l, lds); grid.sync();
    run_step<3>(P, l, lds); grid.sync();
    run_step<4>(P, l, lds); grid.sync();
    run_step<5>(P, l, lds); grid.sync();
    run_step<6>(P, l, lds); grid.sync();
    run_step<7>(P, l, lds); grid.sync();
    run_step<8>(P, l, lds); grid.sync();
    run_step<9>(P, l, lds); grid.sync();
    run_step<10>(P, l, lds); grid.sync();
    run_step<11>(P, l, lds); grid.sync();
  }
  run_step<12>(P, 0, lds);
}
#else
template <int S>
__global__ void __launch_bounds__(256, 2) step_kernel(Params P, int l) {
  __shared__ __attribute__((aligned(16))) char lds[45056];
  run_step<S>(P, l, lds);
}
#endif

extern "C" void kernel_launch(void* const* d_in, const int* in_sizes, int n_in, void* d_out, int out_size, void* d_ws, size_t ws_size,
                              hipStream_t stream) {
  Params P{};
  const float** pin = (const float**)&P;
  for (int i = 0; i < 30; ++i) pin[i] = (const float*)d_in[i];
  P.out = (float*)d_out;
  char* ws = (char*)d_ws;
  size_t off = 0;
  auto alloc = [&](size_t bytes) { char* p = ws + off; off += (bytes + 255) & ~(size_t)255; return p; };
  P.wt_in = (bf16_t*)alloc((size_t)2 * 3072 * 1024 * 2);
  P.wt_out = (bf16_t*)alloc((size_t)2 * 1024 * 1024 * 2);
  P.wt_m1 = (bf16_t*)alloc((size_t)2 * 4096 * 1024 * 2);
  P.wt_m2 = (bf16_t*)alloc((size_t)2 * 4096 * 1024 * 2);
  P.wt_glu = (bf16_t*)alloc((size_t)2 * 256 * 256 * 2);
  P.adap = (float*)alloc((size_t)2 * 16 * 3 * 6144 * 4);
  P.mod = (float*)alloc((size_t)2 * 3 * 6144 * 4);
  P.z = (float*)alloc((size_t)NTOK * 3072 * 4);
  P.hid = (bf16_t*)P.z;
  P.h = (bf16_t*)alloc((size_t)NTOK * 1024 * 2);
  P.mix = (bf16_t*)alloc((size_t)NTOK * 1024 * 2);
  P.xg = (bf16_t*)alloc((size_t)NTOK * 256 * 2);
  P.apow = (float2*)alloc((size_t)64 * 64 * 33 * 8);
  P.bbar = (float2*)alloc((size_t)64 * 64 * 16 * 8);
  P.ktab = (float*)alloc((size_t)64 * 8192 * 4);
  P.atab = (bf16_t*)alloc((size_t)32 * 512 * 768 * 2);
  P.wtab = (bf16_t*)alloc((size_t)32 * 256 * 512 * 2);
  P.bts5 = (bf16_t*)alloc((size_t)16 * 256 * 768 * 2);
  P.E = (float*)alloc((size_t)16 * 256 * 192 * 4);
  P.kv = (float*)alloc((size_t)768 * 4096 * 4);
  P.gdec = (float*)alloc((size_t)768 * 64 * 4);
  P.sst = (float*)alloc((size_t)768 * 4096 * 4);
  if (off > ws_size) { fprintf(stderr, "workspace too small: need %zu have %zu\n", off, ws_size); return; }

#if ONE_LAUNCH
  static int grid_blocks = 0;
  if (!grid_blocks) {
    int dev = 0, cus = 0, per_cu = 0;
    (void)hipGetDevice(&dev);
    (void)hipDeviceGetAttribute(&cus, hipDeviceAttributeMultiprocessorCount, dev);
    (void)hipOccupancyMaxActiveBlocksPerMultiprocessor(&per_cu, mega, 256, 0);
    if (per_cu < 1) per_cu = 1;
    grid_blocks = cus * per_cu;
  }
  void* args[] = {&P};
  hipError_t e = hipLaunchCooperativeKernel((void*)mega, dim3(grid_blocks), dim3(256), args, 0, stream);
  if (e != hipSuccess) fprintf(stderr, "cooperative launch failed: %s (grid %d)\n", hipGetErrorString(e), grid_blocks);
#else
  const int grid_blocks = 512;
  step_kernel<0><<<grid_blocks, 256, 0, stream>>>(P, 0);
  step_kernel<1><<<grid_blocks, 256, 0, stream>>>(P, 0);
  for (int l = 0; l < 2; ++l) {
    step_kernel<2><<<grid_blocks, 256, 0, stream>>>(P, l);
    step_kernel<3><<<grid_blocks, 256, 0, stream>>>(P, l);
    step_kernel<4><<<grid_blocks, 256, 0, stream>>>(P, l);
    step_kernel<5><<<grid_blocks, 256, 0, stream>>>(P, l);
    step_kernel<6><<<grid_blocks, 256, 0, stream>>>(P, l);
    step_kernel<7><<<grid_blocks, 256, 0, stream>>>(P, l);
    step_kernel<8><<<grid_blocks, 256, 0, stream>>>(P, l);
    step_kernel<9><<<grid_blocks, 256, 0, stream>>>(P, l);
    step_kernel<10><<<grid_blocks, 256, 0, stream>>>(P, l);
    step_kernel<11><<<grid_blocks, 256, 0, stream>>>(P, l);
  }
  step_kernel<12><<<grid_blocks, 256, 0, stream>>>(P, 0);
#endif
}
```

```cpp
#include <hip/hip_runtime.h>
#include <hip/hip_cooperative_groups.h>
#include <cstdio>
#include <cstdint>
namespace cg = cooperative_groups;

#ifndef ONE_LAUNCH
#define ONE_LAUNCH 1
#endif

typedef unsigned short bf16_t;
typedef short bf16x8 __attribute__((ext_vector_type(8)));
typedef float f32x4 __attribute__((ext_vector_type(4)));
typedef unsigned u32x4 __attribute__((ext_vector_type(4)));
typedef unsigned u32x2 __attribute__((ext_vector_type(2)));
typedef float f32x2 __attribute__((ext_vector_type(2)));

#define NTOK 6144
#define NCTX 4096
#define NPHASE 23

struct Params {
  const float *x_prompt, *x_sample, *cache_k, *cache_v, *state_s5, *state_hgrn, *c, *c_ctx;
  const float *w_ada, *b_ada, *norm_mix, *norm_mlp, *w_in, *w_out;
  const float *s5_a_re, *s5_a_im, *s5_b_re, *s5_b_im, *s5_c_re, *s5_c_im, *s5_log_dt, *s5_d, *s5_w_glu, *s5_b_glu;
  const float *hg_lb, *hg_norm, *na_rpb, *w_mlp1, *w_mlp2, *norm_final;
  float* out;
  bf16_t *wt_in, *wt_out, *wt_m1, *wt_m2, *wt_glu;
  float *adap, *mod, *uedge;
  bf16_t* z;
  bf16_t *h, *mix, *hid, *xg, *ckb, *cvb;
  float2 *apow, *bbar;
  float* ktab;
  bf16_t *atab, *wtab, *bts5;
  float* E;
  float *kv, *gdec, *sst, *obuf, *pbuf;
  unsigned* bar;
  int use_cg, pad_;
};

typedef const __attribute__((address_space(4))) Params& PRef;
typedef const __attribute__((address_space(4))) Params* PPtr;

#define OUT_CK 6291456
#define OUT_CV 10485760
#define OUT_S5 14680064
#define OUT_HG 14811136

__device__ __forceinline__ int otid() { int t = (int)__builtin_amdgcn_workitem_id_x(); asm volatile("" : "+v"(t)); return t; }
typedef __bf16 bf16x2_native __attribute__((ext_vector_type(2)));
typedef float f32x2_cv __attribute__((ext_vector_type(2)));
__device__ __forceinline__ unsigned pack2(float a, float b) {
  const f32x2_cv v = {a, b};
  return __builtin_bit_cast(unsigned, __builtin_convertvector(v, bf16x2_native));
}
__device__ __forceinline__ bf16_t f2bf(float f) { return __builtin_bit_cast(bf16_t, (__bf16)f); }
__device__ __forceinline__ float bf2f(bf16_t b) { return __uint_as_float(((unsigned)b) << 16); }
__device__ __forceinline__ float sigmoid_(float x) { return 1.f / (1.f + __expf(-x)); }
__device__ __forceinline__ float silu_(float x) { return x * sigmoid_(x); }
__device__ __forceinline__ float gelu_tanh(float y) {
  float t = 0.7978845608028654f * (y + 0.044715f * y * y * y);
  float th = 1.f - 2.f / (__expf(2.f * t) + 1.f);
  return 0.5f * y * (1.f + th);
}
__device__ __forceinline__ float wave_sum(float v) {
#pragma unroll
  for (int o = 32; o > 0; o >>= 1) v += __shfl_xor(v, o);
  return v;
}
__device__ __forceinline__ int variant_of(int n) { return n < NCTX ? 0 : 1 + ((n - NCTX) >> 10); }
__device__ __forceinline__ float lbv(PRef P, int l, int c) {
  if (l == 0) return 0.f;
  float x0 = P.hg_lb[c], x1 = P.hg_lb[256 + c];
  return 1.f / (1.f + __expf(x0 - x1));
}

__device__ __forceinline__ size_t blk_off(int r, int k, int K) {
  return ((size_t)(r >> 7) * (size_t)(K >> 5) + (size_t)(k >> 5)) * 4096 + (size_t)((r & 127) * 32 + (k & 31));
}
template <int NI = 4, bool HOT = false, bool PERM = false, class Epi>
__device__ __forceinline__ void gemm_tile(const bf16_t* __restrict__ A, const bf16_t* __restrict__ B, int nk,
                                          char* lds, Epi epi) {
  const int tid = otid(), lane = tid & 63, w = tid >> 6, wr = w >> 1, wc = w & 1, fr = lane & 15, fq = lane >> 4;
  constexpr int NB = NI / 2;
  f32x4 acc[4][NI];
#pragma unroll
  for (int i = 0; i < 4; ++i)
#pragma unroll
    for (int j = 0; j < NI; ++j) acc[i][j] = (f32x4){0.f, 0.f, 0.f, 0.f};
  u32x4 ra[2], rb[NB];
  const int wsw = (0x1320 >> ((((tid >> 2) >> 2) & 3) * 4)) & 3;
  const int loff0 = (tid >> 2) * 64 + (((tid & 3) ^ wsw) << 4);
  const int rsw = (0x1320 >> (((fr >> 2) & 3) * 4)) & 3;
  const int aoff = (wr * 64 + fr) * 64 + ((fq ^ rsw) << 4);
  const int boff = 8192 + (wc * (16 * NI) + fr) * 64 + ((fq ^ rsw) << 4);
  const bf16_t* Ap = A + tid * 8;
  const bf16_t* Bp = B + tid * 8;
#define GT_LOAD()                                                                          \
  {                                                                                        \
    _Pragma("unroll") for (int i = 0; i < 2; ++i) ra[i] = *(const u32x4*)(Ap + 2048 * i);  \
    _Pragma("unroll") for (int i = 0; i < NB; ++i) rb[i] = *(const u32x4*)(Bp + 2048 * i); \
  }
#define GT_STORE(buf_)                                                                                         \
  {                                                                                                            \
    _Pragma("unroll") for (int i = 0; i < 2; ++i) *(u32x4*)(lds + (buf_) * 16384 + loff0 + 4096 * i) = ra[i];  \
    _Pragma("unroll") for (int i = 0; i < NB; ++i) *(u32x4*)(lds + (buf_) * 16384 + 8192 + loff0 + 4096 * i) = rb[i]; \
  }
  __syncthreads();
  GT_LOAD();
  GT_STORE(0);
  if (nk > 1) { if (!HOT) { Ap += 4096; Bp += 4096; } GT_LOAD(); }
  __syncthreads();
  for (int kt = 0; kt < nk; ++kt) {
    const int cur = kt & 1;
    if (kt + 1 < nk) GT_STORE(cur ^ 1);
    if (kt + 2 < nk) { if (!HOT) { Ap += 4096; Bp += 4096; } GT_LOAD(); }
    __builtin_amdgcn_sched_barrier(0);
    {
      const char* sb = lds + cur * 16384;
      bf16x8 af[4], bfr[NI];
#pragma unroll
      for (int mi = 0; mi < 4; ++mi) af[mi] = *(const bf16x8*)(sb + aoff + 1024 * mi);
#pragma unroll
      for (int ni = 0; ni < NI; ++ni) bfr[ni] = *(const bf16x8*)(sb + boff + 1024 * ni);
#pragma unroll
      for (int mi = 0; mi < 4; ++mi)
#pragma unroll
        for (int ni = 0; ni < NI; ++ni)
          acc[mi][ni] = __builtin_amdgcn_mfma_f32_16x16x32_bf16(bfr[ni], af[mi], acc[mi][ni], 0, 0, 0);
    }
    __syncthreads();
  }
  if constexpr (PERM) {
#pragma unroll
    for (int mi = 0; mi < 4; ++mi)
#pragma unroll
      for (int k = 0; k < NI / 2; ++k) epi(wr * 64 + mi * 16 + fr, wc * (16 * NI) + k * 32 + fq * 8, acc[mi][2 * k], acc[mi][2 * k + 1]);
  } else {
#pragma unroll
    for (int mi = 0; mi < 4; ++mi)
#pragma unroll
      for (int ni = 0; ni < NI; ++ni) epi(wr * 64 + mi * 16 + fr, wc * (16 * NI) + ni * 16 + fq * 4, acc[mi][ni]);
  }
}

__device__ void transpose_tile(const float* __restrict__ src, bf16_t* __restrict__ dst, int K, int N, int t, char* lds) {
  float* T = (float*)lds;
  const int tid = otid();
  const int ntn = N >> 6, kt = t / ntn, nt = t % ntn;
  __syncthreads();
#pragma unroll
  for (int i = 0; i < 4; ++i) {
    const int idx = tid + 256 * i, kr = idx >> 4, n4 = idx & 15;
    const float4 v = *(const float4*)(src + (size_t)(kt * 64 + kr) * N + nt * 64 + n4 * 4);
    T[kr * 65 + n4 * 4 + 0] = v.x; T[kr * 65 + n4 * 4 + 1] = v.y; T[kr * 65 + n4 * 4 + 2] = v.z; T[kr * 65 + n4 * 4 + 3] = v.w;
  }
  __syncthreads();
#pragma unroll
  for (int i = 0; i < 2; ++i) {
    const int idx = tid + 256 * i, n = idx >> 3, kc = idx & 7;
    uint4 o;
    o.x = pack2(T[(kc * 8 + 0) * 65 + n], T[(kc * 8 + 1) * 65 + n]);
    o.y = pack2(T[(kc * 8 + 2) * 65 + n], T[(kc * 8 + 3) * 65 + n]);
    o.z = pack2(T[(kc * 8 + 4) * 65 + n], T[(kc * 8 + 5) * 65 + n]);
    o.w = pack2(T[(kc * 8 + 6) * 65 + n], T[(kc * 8 + 7) * 65 + n]);
    const int cfull = nt * 64 + n, c32 = cfull & 31, rho = ((c32 >> 2) & 1) * 16 + (c32 >> 3) * 4 + (c32 & 3);
    *(uint4*)(dst + blk_off((cfull & ~31) + rho, kt * 64 + kc * 8, K)) = o;
  }
}

__device__ void ada_unit(PRef P, int u, char* lds) {
  float* sv = (float*)lds;
  const int tid = otid();
  const int l = u / 384, r = u % 384, jb = r / 16, ks = r % 16;
  __syncthreads();
  if (tid < 192) {
    const int v = tid >> 6, k = ks * 64 + (tid & 63);
    const float cv = (v == 0) ? P.c_ctx[k] : P.c[(v - 1) * 1024 + k];
    sv[tid] = silu_(cv);
  }
  __syncthreads();
  const int j = jb * 256 + tid;
  const float* wp = P.w_ada + ((size_t)l * 1024 + ks * 64) * 6144 + j;
  float a0 = 0.f, a1 = 0.f, a2 = 0.f;
#pragma unroll 8
  for (int k = 0; k < 64; ++k) {
    const float wv = wp[(size_t)k * 6144];
    a0 += sv[k] * wv; a1 += sv[64 + k] * wv; a2 += sv[128 + k] * wv;
  }
  if (ks == 0) { const float bj = P.b_ada[l * 6144 + j]; a0 += bj; a1 += bj; a2 += bj; }
  float* mp = P.mod + (size_t)(l * 3) * 6144 + j;
  __hip_atomic_fetch_add(mp, a0, __ATOMIC_RELAXED, __HIP_MEMORY_SCOPE_AGENT);
  __hip_atomic_fetch_add(mp + 6144, a1, __ATOMIC_RELAXED, __HIP_MEMORY_SCOPE_AGENT);
  __hip_atomic_fetch_add(mp + 2 * 6144, a2, __ATOMIC_RELAXED, __HIP_MEMORY_SCOPE_AGENT);
}

__device__ void s5pre_unit(PRef P, int u, char* lds) {
  float2* apw = (float2*)lds;
  float2* bb = apw + 64 * 33;
  float2* cc = bb + 64 * 16;
  const int tid = otid();
  const int ldg = u >> 2, part = u & 3;
  __syncthreads();
  {
    const int p = tid & 63, q = tid >> 6;
    const float are = P.s5_a_re[ldg * 64 + p], aim = P.s5_a_im[ldg * 64 + p];
    const float dt = expf(P.s5_log_dt[ldg]);
    for (int k = q; k < 10; k += 4) {
      const int tau = (k < 8) ? part * 8 + k : (k == 8 ? 1 : 32);
      const float mag = expf((float)tau * are * dt);
      const float ang = (float)tau * aim * dt;
      float sn, cs;
      sincosf(ang, &sn, &cs);
      const float2 v = make_float2(mag * cs, mag * sn);
      apw[p * 33 + tau] = v;
      if (k < 8 || (k == 9 && part == 3)) P.apow[((size_t)ldg * 64 + p) * 33 + tau] = v;
    }
  }
  __syncthreads();
  for (int e = tid; e < 1024; e += 256) {
    const int p = e >> 4, hh = e & 15;
    const float are = P.s5_a_re[ldg * 64 + p], aim = P.s5_a_im[ldg * 64 + p];
    const float2 ab = apw[p * 33 + 1];
    const float nr = ab.x - 1.f, ni = ab.y, den = are * are + aim * aim;
    const float cr = (nr * are + ni * aim) / den, ci = (ni * are - nr * aim) / den;
    const float br = P.s5_b_re[((size_t)ldg * 64 + p) * 16 + hh], bi = P.s5_b_im[((size_t)ldg * 64 + p) * 16 + hh];
    const float2 v = make_float2(cr * br - ci * bi, cr * bi + ci * br);
    bb[p * 16 + hh] = v;
    if (part == 0) P.bbar[((size_t)ldg * 64 + p) * 16 + hh] = v;
    const int h2 = e >> 6, p2 = e & 63;
    cc[h2 * 64 + p2] = make_float2(P.s5_c_re[((size_t)ldg * 16 + h2) * 64 + p2], P.s5_c_im[((size_t)ldg * 16 + h2) * 64 + p2]);
  }
  __syncthreads();
  for (int e = tid; e < 2048; e += 256) {
    const int tau = part * 8 + (e >> 8), hh = (e >> 4) & 15, h2 = e & 15;
    float s = 0.f;
    for (int p = 0; p < 64; ++p) {
      const float2 c = cc[hh * 64 + p], a = apw[p * 33 + tau], b = bb[p * 16 + h2];
      const float tr = a.x * b.x - a.y * b.y, ti = a.x * b.y + a.y * b.x;
      s += c.x * tr - c.y * ti;
    }
    P.ktab[(size_t)ldg * 8192 + tau * 256 + (e & 255)] = s;
  }
}

struct TrDesc { const float* src; bf16_t* dst; int K, N, tile; };
__device__ __forceinline__ TrDesc tr_decode(PRef P, int u) {
  TrDesc D;
  if (u < 2048) { const int l = u >> 10; D.src = P.w_mlp1 + (size_t)l * 1024 * 4096; D.dst = P.wt_m1 + (size_t)l * 4096 * 1024; D.K = 1024; D.N = 4096; D.tile = u & 1023; return D; }
  u -= 2048;
  if (u < 2048) { const int l = u >> 10; D.src = P.w_mlp2 + (size_t)l * 4096 * 1024; D.dst = P.wt_m2 + (size_t)l * 1024 * 4096; D.K = 4096; D.N = 1024; D.tile = u & 1023; return D; }
  u -= 2048;
  if (u < 1536) { const int l = u / 768; D.src = P.w_in + (size_t)l * 1024 * 3072; D.dst = P.wt_in + (size_t)l * 3072 * 1024; D.K = 1024; D.N = 3072; D.tile = u % 768; return D; }
  u -= 1536;
  if (u < 512) { const int l = u >> 8; D.src = P.w_out + (size_t)l * 1024 * 1024; D.dst = P.wt_out + (size_t)l * 1024 * 1024; D.K = 1024; D.N = 1024; D.tile = u & 255; return D; }
  u -= 512;
  { const int l = u >> 4; D.src = P.s5_w_glu + (size_t)l * 256 * 256; D.dst = P.wt_glu + (size_t)l * 256 * 256; D.K = 256; D.N = 256; D.tile = u & 15; return D; }
}
#define TR_NTILES 6176
#define TR_LOAD(r_, D_)                                                                                        \
  {                                                                                                            \
    const int ntn_ = (D_).N >> 6, kt_ = (D_).tile / ntn_, nt_ = (D_).tile % ntn_;                              \
    _Pragma("unroll") for (int i = 0; i < 4; ++i) {                                                            \
      const int idx = tid + 256 * i, kr = idx >> 4, n4 = idx & 15;                                             \
      r_[i] = *(const f32x4*)((D_).src + (size_t)(kt_ * 64 + kr) * (D_).N + nt_ * 64 + n4 * 4);               \
    }                                                                                                          \
  }

__device__ void phase0a(PRef P, char* lds) {
  const int tid = otid();
  const int G = gridDim.x;
  for (int u0 = blockIdx.x; u0 < 256 + 768 + 128; u0 += G) {
    int u = u0;
    if (u < 256) { s5pre_unit(P, u, lds); continue; }
    u -= 256;
    if (u < 768) { ada_unit(P, u, lds); continue; }
    u -= 768;
    {
      const int c = u, which = c >> 6;
      const float* src = (which ? P.cache_v : P.cache_k) + (size_t)(c & 63) * 16384;
      bf16_t* dst = (which ? P.cvb : P.ckb) + (size_t)(c & 63) * 16384;
#pragma unroll
      for (int i = 0; i < 8; ++i) {
        const int e = (tid + 256 * i) * 8;
        const f32x4 a = *(const f32x4*)(src + e), b = *(const f32x4*)(src + e + 4);
        u32x4 o; o.x = pack2(a[0], a[1]); o.y = pack2(a[2], a[3]); o.z = pack2(b[0], b[1]); o.w = pack2(b[2], b[3]);
        *(u32x4*)(dst + e) = o;
      }
    }
  }
  float* T = (float*)lds;
  int t = blockIdx.x;
  f32x4 r[4], rn[4];
  TrDesc D = tr_decode(P, t < TR_NTILES ? t : 0), Dn = D;
  if (t < TR_NTILES) TR_LOAD(r, D);
  while (t < TR_NTILES) {
    const int tn = t + G;
    if (tn < TR_NTILES) { Dn = tr_decode(P, tn); TR_LOAD(rn, Dn); }
    __syncthreads();
#pragma unroll
    for (int i = 0; i < 4; ++i) {
      const int idx = tid + 256 * i, kr = idx >> 4, n4 = idx & 15;
      T[kr * 65 + n4 * 4 + 0] = r[i][0]; T[kr * 65 + n4 * 4 + 1] = r[i][1]; T[kr * 65 + n4 * 4 + 2] = r[i][2]; T[kr * 65 + n4 * 4 + 3] = r[i][3];
    }
    __syncthreads();
    {
      const int ntn = D.N >> 6, kt = D.tile / ntn, nt = D.tile % ntn;
#pragma unroll
      for (int i = 0; i < 2; ++i) {
        const int idx = tid + 256 * i, n = idx >> 3, kc = idx & 7;
        u32x4 o;
        o.x = pack2(T[(kc * 8 + 0) * 65 + n], T[(kc * 8 + 1) * 65 + n]);
        o.y = pack2(T[(kc * 8 + 2) * 65 + n], T[(kc * 8 + 3) * 65 + n]);
        o.z = pack2(T[(kc * 8 + 4) * 65 + n], T[(kc * 8 + 5) * 65 + n]);
        o.w = pack2(T[(kc * 8 + 6) * 65 + n], T[(kc * 8 + 7) * 65 + n]);
        const int cfull = nt * 64 + n, c32 = cfull & 31, rho = ((c32 >> 2) & 1) * 16 + (c32 >> 3) * 4 + (c32 & 3);
        *(u32x4*)(D.dst + blk_off((cfull & ~31) + rho, kt * 64 + kc * 8, D.K)) = o;
      }
    }
#pragma unroll
    for (int i = 0; i < 4; ++i) r[i] = rn[i];
    D = Dn;
    t = tn;
  }
}

__device__ void phase0b(PRef P) {
  const size_t gtid = (size_t)blockIdx.x * 256 + otid(), gsz = (size_t)gridDim.x * 256;
}

__device__ void tables_expand(PRef P) {
  const size_t gtid = (size_t)blockIdx.x * 256 + otid(), gsz = (size_t)gridDim.x * 256;
  for (size_t e8 = gtid; e8 < (size_t)2 * 16 * 512 * 96; e8 += gsz) {
    const int k0 = (int)(e8 % 96) * 8;
    const int m = (int)((e8 / 96) % 512);
    const int lg = (int)(e8 / (96 * 512));
    const int l = lg >> 4, g = lg & 15, i = m >> 4, hh = m & 15;
    const int ldg0 = (l * 2 + 0) * 16 + g, ldg1 = (l * 2 + 1) * 16 + g;
    float v[8];
    if (k0 < 512) {
      const int j = k0 >> 4, h2 = k0 & 15;
      f32x4 a0 = (f32x4){0.f, 0.f, 0.f, 0.f}, a1 = a0, b0 = a0, b1 = a0;
      if (j <= i) { const float* kp = P.ktab + (size_t)ldg0 * 8192 + (i - j) * 256 + hh * 16 + h2; a0 = *(const f32x4*)kp; a1 = *(const f32x4*)(kp + 4); }
      if (j >= i) { const float* kp = P.ktab + (size_t)ldg1 * 8192 + (j - i) * 256 + hh * 16 + h2; b0 = *(const f32x4*)kp; b1 = *(const f32x4*)(kp + 4); }
      const float dsk = P.s5_d[l * 256 + g * 16 + hh];
#pragma unroll
      for (int q = 0; q < 4; ++q) { v[q] = a0[q] + b0[q]; v[4 + q] = a1[q] + b1[q]; }
      if (j == i && hh >= h2 && hh < h2 + 8) {
#pragma unroll
        for (int q = 0; q < 8; ++q) if (q == hh - h2) v[q] += dsk;
      }
    } else {
      const int d = (k0 >= 640) ? 1 : 0;
      const int p0 = ((k0 - 512) & 127) >> 1;
      const int ldg = d ? ldg1 : ldg0;
      const int pw = d ? (32 - i) : (i + 1);
      const f32x4 cr = *(const f32x4*)(P.s5_c_re + ((size_t)ldg * 16 + hh) * 64 + p0), ci = *(const f32x4*)(P.s5_c_im + ((size_t)ldg * 16 + hh) * 64 + p0);
      float2 a[4];
#pragma unroll
      for (int q = 0; q < 4; ++q) a[q] = P.apow[((size_t)ldg * 64 + p0 + q) * 33 + pw];
#pragma unroll
      for (int q = 0; q < 4; ++q) { v[2 * q] = cr[q] * a[q].x - ci[q] * a[q].y; v[2 * q + 1] = -(cr[q] * a[q].y + ci[q] * a[q].x); }
    }
    u32x4 o; o.x = pack2(v[0], v[1]); o.y = pack2(v[2], v[3]); o.z = pack2(v[4], v[5]); o.w = pack2(v[6], v[7]);
    *(u32x4*)(P.atab + (size_t)lg * 512 * 768 + blk_off(m, k0, 768)) = o;
  }
  for (size_t e8 = gtid; e8 < (size_t)2 * 16 * 256 * 64; e8 += gsz) {
    const int k0 = (int)(e8 % 64) * 8;
    const int row = (int)((e8 / 64) % 256);
    const int lg = (int)(e8 / (64 * 256));
    const int l = lg >> 4, g = lg & 15;
    const int d = row >> 7, p = (row & 127) >> 1, ri = row & 1;
    const int ldg = (l * 2 + d) * 16 + g;
    const int j = k0 >> 4, h2 = k0 & 15;
    const int pw = d ? j : (31 - j);
    const float2 a = P.apow[((size_t)ldg * 64 + p) * 33 + pw];
    const f32x4* bp = (const f32x4*)(P.bbar + ((size_t)ldg * 64 + p) * 16 + h2);
    const f32x4 b0 = bp[0], b1 = bp[1], b2 = bp[2], b3 = bp[3];
    const float br[8] = {b0[0], b0[2], b1[0], b1[2], b2[0], b2[2], b3[0], b3[2]};
    const float bi[8] = {b0[1], b0[3], b1[1], b1[3], b2[1], b2[3], b3[1], b3[3]};
    float v[8];
#pragma unroll
    for (int q = 0; q < 8; ++q) v[q] = ri ? (a.x * bi[q] + a.y * br[q]) : (a.x * br[q] - a.y * bi[q]);
    u32x4 o; o.x = pack2(v[0], v[1]); o.y = pack2(v[2], v[3]); o.z = pack2(v[4], v[5]); o.w = pack2(v[6], v[7]);
    *(u32x4*)(P.wtab + (size_t)lg * 256 * 512 + blk_off(row, k0, 512)) = o;
  }
}

__device__ void normmod_phase(PRef P, int l, int which) {
  const int lane = otid() & 63, w = otid() >> 6;
  const float* gam = (which == 0 ? P.norm_mix : P.norm_mlp) + l * 1024;
  const bool addp = (which == 0 && l > 0);
  for (int n = blockIdx.x * 4 + w; n < NTOK; n += gridDim.x * 4) {
    float* xr = P.out + (size_t)n * 1024;
    const float* xin = (l == 0 && which == 0) ? (n < NCTX ? P.x_prompt + (size_t)n * 1024 : P.x_sample + (size_t)(n - NCTX) * 1024) : xr;
    const float* md = P.mod + ((size_t)(l * 3 + variant_of(n))) * 6144 + (which == 0 ? 0 : 3072);
    f32x4 v[4];
    float ss = 0.f;
#pragma unroll
    for (int i = 0; i < 4; ++i) {
      const int k = lane * 8 + 512 * (i >> 1) + 4 * (i & 1);
      v[i] = *(const f32x4*)(xin + k);
      if (addp) {
        v[i] = v[i] + *(const f32x4*)(P.pbuf + (size_t)n * 1024 + k);
        *(f32x4*)(xr + k) = v[i];
      }
      ss += v[i][0] * v[i][0] + v[i][1] * v[i][1] + v[i][2] * v[i][2] + v[i][3] * v[i][3];
    }
    f32x4 gq[4], shq[4], scq[4];
#pragma unroll
    for (int i = 0; i < 4; ++i) {
      const int k = lane * 8 + 512 * (i >> 1) + 4 * (i & 1);
      gq[i] = *(const f32x4*)(gam + k); shq[i] = *(const f32x4*)(md + k); scq[i] = *(const f32x4*)(md + 1024 + k);
    }
    ss = wave_sum(ss);
    const float rstd = rsqrtf(ss * (1.f / 1024.f) + 1e-6f);
#pragma unroll
    for (int j = 0; j < 2; ++j) {
      const int k = lane * 8 + 512 * j;
      const f32x4 o0 = v[2 * j] * rstd * gq[2 * j] * (1.f + scq[2 * j]) + shq[2 * j];
      const f32x4 o1 = v[2 * j + 1] * rstd * gq[2 * j + 1] * (1.f + scq[2 * j + 1]) + shq[2 * j + 1];
      u32x4 ov; ov.x = pack2(o0[0], o0[1]); ov.y = pack2(o0[2], o0[3]); ov.z = pack2(o1[0], o1[1]); ov.w = pack2(o1[2], o1[3]);
      *(u32x4*)(P.h + blk_off(n, k, 1024)) = ov;
    }
  }
  if (l == 0 && which == 0) tables_expand(P);
}

__device__ void final_phase(PRef P) {
  const int lane = otid() & 63, w = otid() >> 6;
  for (int n = blockIdx.x * 4 + w; n < NTOK; n += gridDim.x * 4) {
    float* xr = P.out + (size_t)n * 1024;
    f32x4 v[4];
    float ss = 0.f;
#pragma unroll
    for (int i = 0; i < 4; ++i) {
      v[i] = *(const f32x4*)(xr + lane * 4 + 256 * i) + *(const f32x4*)(P.pbuf + (size_t)n * 1024 + lane * 4 + 256 * i);
      ss += v[i][0] * v[i][0] + v[i][1] * v[i][1] + v[i][2] * v[i][2] + v[i][3] * v[i][3];
    }
    ss = wave_sum(ss);
    const float rstd = rsqrtf(ss * (1.f / 1024.f) + 1e-6f);
#pragma unroll
    for (int i = 0; i < 4; ++i) {
      const int k = lane * 4 + 256 * i;
      const f32x4 g = *(const f32x4*)(P.norm_final + k);
      *(f32x4*)(xr + k) = v[i] * rstd * g;
    }
  }
}

__device__ void win_phase(PRef P, int l, char* lds) {
  for (int u = blockIdx.x; u < 48 * 24; u += gridDim.x) {
    const int mt = u / 24, nt = u % 24, m0 = mt * 128, n0 = nt * 128;
    gemm_tile<4, false, true>(P.h + blk_off(m0, 0, 1024), P.wt_in + (size_t)l * 3072 * 1024 + blk_off(n0, 0, 1024), 32, lds,
      [&](int rl, int cl, f32x4 v, f32x4 w2) {
        const int n = m0 + rl, c = n0 + cl;
        u32x4 zo; zo.x = pack2(v[0], v[1]); zo.y = pack2(v[2], v[3]); zo.z = pack2(w2[0], w2[1]); zo.w = pack2(w2[2], w2[3]);
        *(u32x4*)(P.z + (size_t)n * 3072 + c) = zo;
        if (c < 256) {
          if (n < NCTX && ((n & 255) == 0 || (n & 255) == 255)) {
            float* ue = P.uedge + (size_t)((n >> 8) * 2 + ((n & 255) ? 1 : 0)) * 256 + c;
            *(f32x4*)ue = v; *(f32x4*)(ue + 4) = w2;
          }
          const int g = c >> 4;
          *(u32x4*)(P.bts5 + (size_t)g * 256 * 768 + blk_off(n >> 5, (n & 31) * 16 + (c & 15), 768)) = zo;
        }
        if (c >= 2048 && n < NCTX) {
          const int b = n >> 8, t = n & 255;
          float* dst = P.out + (c < 2560 ? OUT_CK : OUT_CV) + ((size_t)((b * 2 + l) * 256 + t)) * 512 + ((c - 2048) & 511);
          *(f32x4*)dst = v; *(f32x4*)(dst + 4) = w2;
        }
      });
  }
}

template <bool DUMMY = false>
__device__ void wout_phase(PRef P, int l, char* lds) {
  for (int u = blockIdx.x; u < 48 * 16; u += gridDim.x) {
    const int mt = u / 16, nt = u % 16, m0 = mt * 128, n0 = nt * 64;
    gemm_tile<2, false, true>(P.mix + blk_off(m0, 0, 1024), P.wt_out + (size_t)l * 1024 * 1024 + blk_off(n0, 0, 1024), 32, lds,
      [&](int rl, int cl, f32x4 v, f32x4 w2) {
        const int n = m0 + rl, c = n0 + cl;
        const float* gp = P.mod + ((size_t)(l * 3 + variant_of(n))) * 6144 + 2048 + c;
        f32x4* xp = (f32x4*)((DUMMY ? P.kv : P.out) + (size_t)n * 1024 + c);
        const f32x4* xs = (l == 0) ? (const f32x4*)((n < NCTX ? P.x_prompt + (size_t)n * 1024 : P.x_sample + (size_t)(n - NCTX) * 1024) + c) : xp;
        const f32x4 x0 = xs[0], x1 = xs[1];
        xp[0] = x0 + *(const f32x4*)gp * v; xp[1] = x1 + *(const f32x4*)(gp + 4) * w2;
      });
  }
}

__device__ void mlp1_phase(PRef P, int l, char* lds) {
  for (int u = blockIdx.x; u < 48 * 32; u += gridDim.x) {
    const int mt = u / 32, nt = u % 32, m0 = mt * 128, n0 = nt * 128;
    gemm_tile<4, false, true>(P.h + blk_off(m0, 0, 1024), P.wt_m1 + (size_t)l * 4096 * 1024 + blk_off(n0, 0, 1024), 32, lds,
      [&](int rl, int cl, f32x4 v, f32x4 w2) {
        const int n = m0 + rl, c = n0 + cl;
        const f32x4 z4 = (f32x4){0.f, 0.f, 0.f, 0.f};
        const f32x4 a = __builtin_elementwise_max(v, z4), b = __builtin_elementwise_max(w2, z4);
        const f32x4 aa = a * a, bb = b * b;
        u32x4 o; o.x = pack2(aa[0], aa[1]); o.y = pack2(aa[2], aa[3]); o.z = pack2(bb[0], bb[1]); o.w = pack2(bb[2], bb[3]);
        *(u32x4*)(P.hid + blk_off(n, c, 4096)) = o;
      });
  }
}

template <bool HOT>
__device__ void mlp1_dummy_phase(PRef P, int l, char* lds) {
  for (int u = blockIdx.x; u < 48 * 32; u += gridDim.x) {
    const int mt = u / 32, nt = u % 32, m0 = mt * 128, n0 = nt * 128;
    gemm_tile<4, HOT>(P.h + blk_off(m0, 0, 1024), P.wt_m1 + (size_t)l * 4096 * 1024 + blk_off(n0, 0, 1024), 32, lds,
      [&](int rl, int cl, f32x4 v) {
        if (v[0] == 12345.678f) P.kv[rl * 128 + cl] = v[1];
      });
  }
}

template <bool DUMMY = false>
__device__ void mlp2_phase(PRef P, int l, char* lds) {
  for (int u = blockIdx.x; u < 48 * 8 * 2; u += gridDim.x) {
    const int ks = u & 1, t = u >> 1, mt = t / 8, nt = t % 8, m0 = mt * 128, n0 = nt * 128;
    gemm_tile<4, false, true>(P.hid + blk_off(m0, ks * 2048, 4096), P.wt_m2 + (size_t)l * 1024 * 4096 + blk_off(n0, ks * 2048, 4096), 64, lds,
      [&](int rl, int cl, f32x4 v, f32x4 w2) {
        const int n = m0 + rl, c = n0 + cl;
        const float* gp = P.mod + ((size_t)(l * 3 + variant_of(n))) * 6144 + 5120 + c;
        const f32x4 g0 = *(const f32x4*)gp, g1 = *(const f32x4*)(gp + 4);
        if (ks == 0) {
          f32x4* xp = (f32x4*)((DUMMY ? P.kv : P.out) + (size_t)n * 1024 + c);
          const f32x4 x0 = xp[0], x1 = xp[1];
          xp[0] = x0 + g0 * v; xp[1] = x1 + g1 * w2;
        } else {
          f32x4* pp = (f32x4*)((DUMMY ? P.kv : P.pbuf) + (size_t)n * 1024 + c);
          pp[0] = g0 * v; pp[1] = g1 * w2;
        }
      });
  }
}

__device__ void s5e_unit(PRef P, int l, int u, char* lds) {
  const int g = u >> 2, mt = (u >> 1) & 1, nt = u & 1;
  gemm_tile(P.bts5 + (size_t)g * 256 * 768 + blk_off(nt * 128, 0, 768), P.wtab + (size_t)(l * 16 + g) * 256 * 512 + blk_off(mt * 128, 0, 512), 16, lds,
    [&](int rl, int cl, f32x4 v) {
      const int col = nt * 128 + rl, m = mt * 128 + cl;
      if (col < 192) *(f32x4*)(P.E + ((size_t)(g * 192 + col)) * 256 + m) = v;
    });
}

__device__ void s5y_unit(PRef P, int l, int u, char* lds) {
  const int g = u >> 4, mt = (u >> 1) & 7, nt = u & 1;
  gemm_tile<2>(P.bts5 + (size_t)g * 256 * 768 + blk_off(nt * 128, 0, 768), P.atab + (size_t)(l * 16 + g) * 512 * 768 + blk_off(mt * 64, 0, 768), 24, lds,
    [&](int rl, int cl, f32x4 v) {
      const int col = nt * 128 + rl, m = mt * 64 + cl;
      if (col < 192) {
        const int i = m >> 4, hh = m & 15, n = col * 32 + i;
        uint2 o; o.x = pack2(gelu_tanh(v[0]), gelu_tanh(v[1])); o.y = pack2(gelu_tanh(v[2]), gelu_tanh(v[3]));
        *(uint2*)(P.xg + blk_off(n, g * 16 + hh, 256)) = o;
      }
    });
}

__device__ void glu_unit(PRef P, int l, int u, char* lds) {
  {
    const int mt = u >> 1, nt = u & 1, m0 = mt * 128, n0 = nt * 128;
    gemm_tile<4, false, true>(P.xg + blk_off(m0, 0, 256), P.wt_glu + (size_t)l * 256 * 256 + blk_off(n0, 0, 256), 8, lds,
      [&](int rl, int cl, f32x4 v, f32x4 w2) {
        const int n = m0 + rl, c = n0 + cl;
        const u32x4 xv = *(const u32x4*)(P.xg + blk_off(n, c, 256));
        const float* bp = P.s5_b_glu + l * 256 + c;
        const f32x4 b0 = *(const f32x4*)bp, b1 = *(const f32x4*)(bp + 4);
        u32x4 o;
        o.x = pack2(bf2f((bf16_t)(xv.x & 0xffff)) * sigmoid_(v[0] + b0[0]), bf2f((bf16_t)(xv.x >> 16)) * sigmoid_(v[1] + b0[1]));
        o.y = pack2(bf2f((bf16_t)(xv.y & 0xffff)) * sigmoid_(v[2] + b0[2]), bf2f((bf16_t)(xv.y >> 16)) * sigmoid_(v[3] + b0[3]));
        o.z = pack2(bf2f((bf16_t)(xv.z & 0xffff)) * sigmoid_(w2[0] + b1[0]), bf2f((bf16_t)(xv.z >> 16)) * sigmoid_(w2[1] + b1[1]));
        o.w = pack2(bf2f((bf16_t)(xv.w & 0xffff)) * sigmoid_(w2[2] + b1[2]), bf2f((bf16_t)(xv.w >> 16)) * sigmoid_(w2[3] + b1[3]));
        *(u32x4*)(P.mix + blk_off(n, c, 1024)) = o;
      });
  }
}

__device__ void attn_unit(PRef P, int l, int unit, char* lds) {
  char* Ks = lds;
  bf16_t* Vt = (bf16_t*)(lds + 8192);
  float* rpbS = (float*)(lds + 8192 + 64 * 68 * 2);
  const int tid = otid(), lane = tid & 63, w = tid >> 6, fr = lane & 15, fq = lane >> 4;
  const bool lat = unit < 256;
  int b, h, qrow0, ntiles, r = 0, r_start = 0;
  if (lat) { b = unit >> 7; h = (unit >> 4) & 7; r = unit & 15; qrow0 = NCTX + b * 1024 + r * 64; ntiles = 16; r_start = min(max(r - 4, 0), 8); }
  else { const int v = unit - 256; b = v >> 5; h = (v >> 2) & 7; qrow0 = b * 256 + (v & 3) * 64; ntiles = 4; }
  __syncthreads();
  if (lat) for (int i = tid; i < 465; i += 256) rpbS[i] = P.na_rpb[(size_t)((l * 8 + h) * 15) * 31 + i];
  bf16x8 qf[2];
  {
    const bf16_t* zq = P.z + (size_t)(qrow0 + w * 16 + fr) * 3072 + 1536 + h * 64;
#pragma unroll
    for (int ks = 0; ks < 2; ++ks) {
      const bf16x8 a = *(const bf16x8*)(zq + ks * 32 + fq * 8);
#pragma unroll
      for (int j = 0; j < 8; ++j) qf[ks][j] = (short)f2bf(bf2f((bf16_t)a[j]) * 0.125f);
    }
  }
  const int bandw = __builtin_amdgcn_readfirstlane(min(max(w * 16 - 8, 0), 32));
  float m = -INFINITY, lsum = 0.f;
  f32x4 o[4];
#pragma unroll
  for (int i = 0; i < 4; ++i) o[i] = (f32x4){0.f, 0.f, 0.f, 0.f};
  u32x4 kr[2], vr[2];
#define ATT_LOAD_TILE(t_)                                                                                              \
  {                                                                                                                    \
    const int tt = (t_);                                                                                               \
    const bf16_t* kp; const bf16_t* vp; int ld;                                                                        \
    if (lat && tt < 8) {                            \
      const size_t base = ((size_t)((b * 2 + l) * 512 + tt * 64)) * 512 + h * 64;                                      \
      kp = P.ckb + base; vp = P.cvb + base; ld = 512;                                                                  \
    } else {                                                            \
      const int row0 = lat ? (NCTX + b * 1024 + (r_start + tt - 8) * 64) : (b * 256 + tt * 64);                        \
      kp = P.z + (size_t)row0 * 3072 + 2048 + h * 64; vp = kp + 512; ld = 3072;                                        \
    }                                                                                                                  \
    _Pragma("unroll") for (int i = 0; i < 2; ++i) {                                                                    \
      const int c = tid + 256 * i, key = c >> 3, ch = c & 7;                                                           \
      kr[i] = *(const u32x4*)(kp + (size_t)key * ld + ch * 8);                                                         \
      vr[i] = *(const u32x4*)(vp + (size_t)key * ld + ch * 8);                                                         \
    }                                                                                                                  \
  }
  ATT_LOAD_TILE(0);
  for (int t = 0; t < ntiles; ++t) {
    __syncthreads();
#pragma unroll
    for (int i = 0; i < 2; ++i) {
      const int c = tid + 256 * i, key = c >> 3, ch = c & 7;
      *(u32x4*)(Ks + key * 128 + ((ch ^ ((key >> 1) & 7)) << 4)) = kr[i];
      const u32x4 vb = vr[i];
#pragma unroll
      for (int e = 0; e < 4; ++e) {
        Vt[(ch * 8 + 2 * e) * 68 + key] = (bf16_t)(vb[e] & 0xffffu);
        Vt[(ch * 8 + 2 * e + 1) * 68 + key] = (bf16_t)(vb[e] >> 16);
      }
    }
    __syncthreads();
    if (t + 1 < ntiles) ATT_LOAD_TILE(t + 1);
    __builtin_amdgcn_sched_barrier(0);
    const bool win = lat && t >= 8;
    const int band = win ? bandw : 0;
    const int nkt = win ? 2 : 4;
    f32x4 s[4];
#pragma unroll
    for (int kt = 0; kt < 4; ++kt) {
      if (kt < nkt) {
        s[kt] = (f32x4){0.f, 0.f, 0.f, 0.f};
        const int key = band + kt * 16 + fr;
#pragma unroll
        for (int ks = 0; ks < 2; ++ks) {
          const bf16x8 a = *(const bf16x8*)(Ks + key * 128 + (((ks * 4 + fq) ^ ((key >> 1) & 7)) << 4));
          s[kt] = __builtin_amdgcn_mfma_f32_16x16x32_bf16(a, qf[ks], s[kt], 0, 0, 0);
        }
      } else {
        s[kt] = (f32x4){-1e30f, -1e30f, -1e30f, -1e30f};
      }
    }
    if (win) {
      const int dr = r_start + (t - 8) - r + 7;
      const int qc = w * 16 + fr;
      const int cs = min(max(qc - 8, 0), 48);
#pragma unroll
      for (int kt = 0; kt < 2; ++kt)
#pragma unroll
        for (int rr = 0; rr < 4; ++rr) {
          const int kc = band + kt * 16 + fq * 4 + rr;
          const bool in = (kc >= cs) && (kc < cs + 16);
          const int dc = min(max(kc - qc + 15, 0), 30);
          s[kt][rr] = in ? s[kt][rr] + rpbS[dr * 31 + dc] : -1e30f;
        }
    }
    float mx = -INFINITY;
#pragma unroll
    for (int kt = 0; kt < 4; ++kt)
#pragma unroll
      for (int rr = 0; rr < 4; ++rr) mx = fmaxf(mx, s[kt][rr]);
    mx = fmaxf(mx, __shfl_xor(mx, 16));
    mx = fmaxf(mx, __shfl_xor(mx, 32));
    const float mn = fmaxf(m, mx);
    const float alpha = __expf(m - mn);
    float ps = 0.f;
#pragma unroll
    for (int kt = 0; kt < 4; ++kt)
#pragma unroll
      for (int rr = 0; rr < 4; ++rr) { s[kt][rr] = __expf(s[kt][rr] - mn); ps += s[kt][rr]; }
    ps += __shfl_xor(ps, 16);
    ps += __shfl_xor(ps, 32);
    lsum = lsum * alpha + ps;
    m = mn;
#pragma unroll
    for (int i = 0; i < 4; ++i) o[i] = o[i] * alpha;
#pragma unroll
    for (int c = 0; c < 2; ++c) {
      if (2 * c >= nkt) continue;
      const bf16x8 pb = __builtin_bit_cast(bf16x8, (u32x4){pack2(s[2 * c][0], s[2 * c][1]), pack2(s[2 * c][2], s[2 * c][3]),
                                                             pack2(s[2 * c + 1][0], s[2 * c + 1][1]), pack2(s[2 * c + 1][2], s[2 * c + 1][3])});
#pragma unroll
      for (int dt = 0; dt < 4; ++dt) {
        const int d = dt * 16 + fr;
        const u32x2 lo = *(const u32x2*)(Vt + d * 68 + band + (2 * c) * 16 + fq * 4);
        const u32x2 hi = *(const u32x2*)(Vt + d * 68 + band + (2 * c + 1) * 16 + fq * 4);
        const u32x4 avu = (u32x4){lo.x, lo.y, hi.x, hi.y};
        o[dt] = __builtin_amdgcn_mfma_f32_16x16x32_bf16(__builtin_bit_cast(bf16x8, avu), pb, o[dt], 0, 0, 0);
      }
    }
  }
  const float inv = 1.f / lsum;
#pragma unroll
  for (int dt = 0; dt < 4; ++dt) {
    uint2 ov; ov.x = pack2(o[dt][0] * inv, o[dt][1] * inv); ov.y = pack2(o[dt][2] * inv, o[dt][3] * inv);
    *(uint2*)(P.mix + blk_off(qrow0 + w * 16 + fr, 512 + h * 64 + dt * 16 + fq * 4, 1024)) = ov;
  }
}

__device__ void hgrn_a_unit(PRef P, int l, int unit, char* lds) {
  float* fS = (float*)lds;
  float* vS = fS + 4096;
  const int tid = otid(), dv = tid & 63, q4 = tid >> 6;
  const int mc = unit >> 3, h = (unit >> 1) & 3, d = unit & 1, n0 = mc * 64;
  const int zfcol = (d == 0 ? 512 : 768) + h * 64;
  __syncthreads();
#pragma unroll 4
  for (int e = 0; e < 16; ++e) {
    const int idx = tid + 256 * e, s = idx >> 6, ch = idx & 63;
    const bf16_t* zrow = P.z + (size_t)(n0 + s) * 3072;
    const float lb = lbv(P, l, h * 64 + ch);
    fS[idx] = lb + (1.f - lb) * sigmoid_(bf2f(zrow[zfcol + ch]));
    vS[idx] = bf2f(zrow[1024 + h * 64 + ch]);
  }
  __syncthreads();
  f32x2 S[8];
#pragma unroll
  for (int j = 0; j < 8; ++j) S[j] = (f32x2){0.f, 0.f};
  for (int i = 0; i < 64; ++i) {
    const int s = d ? 63 - i : i;
    const float vv = vS[s * 64 + dv];
    const f32x2 vv2 = (f32x2){vv, vv};
#pragma unroll
    for (int j = 0; j < 8; ++j) {
      const f32x2 fv = *(const f32x2*)(fS + s * 64 + q4 * 16 + 2 * j);
      S[j] = fv * (S[j] - vv2) + vv2;
    }
  }
#pragma unroll
  for (int j = 0; j < 8; ++j) {
    P.kv[((size_t)unit * 64 + q4 * 16 + 2 * j) * 64 + dv] = S[j][0];
    P.kv[((size_t)unit * 64 + q4 * 16 + 2 * j + 1) * 64 + dv] = S[j][1];
  }
  if (tid < 64) {
    float g = 1.f;
    for (int s = 0; s < 64; ++s) g *= fS[s * 64 + tid];
    P.gdec[unit * 64 + tid] = g;
  }
}

__device__ void hgrn_b_unit(PRef P, int l, int unit, char* lds) {
  float* fS = (float*)lds;
  float* qS = fS + 1024;
  float* vS = qS + 1024;
  float* opart = vS + 1024;
  const int tid = otid(), dv = tid & 63, q4 = tid >> 6;
  const int mc = unit >> 3, h = (unit >> 1) & 3, d = unit & 1, n0 = mc * 64;
  f32x2 S[8];
#pragma unroll
  for (int j = 0; j < 8; ++j) {
    S[j][0] = P.sst[((size_t)unit * 64 + q4 * 16 + 2 * j) * 64 + dv];
    S[j][1] = P.sst[((size_t)unit * 64 + q4 * 16 + 2 * j + 1) * 64 + dv];
  }
  const int zfcol = (d == 0 ? 512 : 768) + h * 64;
  float rf[4], rq[4], rv[4], rlb[4];
#pragma unroll
  for (int e = 0; e < 4; ++e) rlb[e] = lbv(P, l, h * 64 + ((tid + 256 * e) & 63));
#define HG_LOAD(sub_)                                                                              \
  _Pragma("unroll") for (int e = 0; e < 4; ++e) {                                                  \
    const int idx = tid + 256 * e, i = idx >> 6, ch = idx & 63, tl = (sub_) * 16 + i, s = d ? 63 - tl : tl; \
    const bf16_t* zrow = P.z + (size_t)(n0 + s) * 3072;                                           \
    rf[e] = bf2f(zrow[zfcol + ch]); rq[e] = bf2f(zrow[256 + h * 64 + ch]); rv[e] = bf2f(zrow[1024 + h * 64 + ch]);  \
  }
  HG_LOAD(0);
  for (int sub = 0; sub < 4; ++sub) {
    __syncthreads();
#pragma unroll
    for (int e = 0; e < 4; ++e) {
      const int idx = tid + 256 * e;
      fS[idx] = rlb[e] + (1.f - rlb[e]) * sigmoid_(rf[e]);
      qS[idx] = silu_(rq[e]);
      vS[idx] = rv[e];
    }
    __syncthreads();
    if (sub + 1 < 4) HG_LOAD(sub + 1);
    __builtin_amdgcn_sched_barrier(0);
    for (int i = 0; i < 16; ++i) {
      f32x2 po = (f32x2){0.f, 0.f};
      const float vv = vS[i * 64 + dv];
      const f32x2 vv2 = (f32x2){vv, vv};
#pragma unroll
      for (int j = 0; j < 8; ++j) {
        const f32x2 fv = *(const f32x2*)(fS + i * 64 + q4 * 16 + 2 * j);
        const f32x2 qv = *(const f32x2*)(qS + i * 64 + q4 * 16 + 2 * j);
        S[j] = fv * (S[j] - vv2) + vv2;
        po = S[j] * qv + po;
      }
      opart[(q4 * 16 + i) * 64 + dv] = po[0] + po[1];
    }
    __syncthreads();
#pragma unroll
    for (int e = 0; e < 4; ++e) {
      const int idx = tid + 256 * e, i = idx >> 6, dvv = idx & 63, tl = sub * 16 + i, s = d ? 63 - tl : tl;
      const float sum = opart[(0 * 16 + i) * 64 + dvv] + opart[(1 * 16 + i) * 64 + dvv] + opart[(2 * 16 + i) * 64 + dvv] + opart[(3 * 16 + i) * 64 + dvv];
      P.obuf[((size_t)d * NTOK + n0 + s) * 256 + h * 64 + dvv] = sum;
    }
  }
}

template <bool OUT>
__device__ void hgrn_mfma_unit(PRef P, int l, int su, char* lds) {
  const int tid = otid(), lane = tid & 63, w = tid >> 6, fr = lane & 15, fq = lane >> 4;
  const int mc = su >> 3, h = (su >> 1) & 3, d = su & 1, n0 = mc * 64;
  const int zfcol = (d == 0 ? 512 : 768) + h * 64;
  __syncthreads();
  {
    const int sub = w;
    char* wl = lds + sub * 10752;
    bf16_t* qa = (bf16_t*)wl;
    bf16_t* qs = qa + 1024;
    bf16_t* ka = qs + 1024;
    bf16_t* kT = ka + 1024;
    bf16_t* vT = kT + 1024;
    float* gS = (float*)(vT + 1024);
    const float lb = lbv(P, l, h * 64 + lane);
    float bc[16], kk[16], vv[16], qq[16];
#pragma unroll
    for (int i = 0; i < 16; ++i) {
      const int tl = sub * 16 + i, st = d ? 63 - tl : tl;
      const bf16_t* zrow = P.z + (size_t)(n0 + st) * 3072;
      kk[i] = bf2f(zrow[zfcol + lane]);
      vv[i] = bf2f(zrow[1024 + h * 64 + lane]);
      if (OUT) qq[i] = bf2f(zrow[256 + h * 64 + lane]);
    }
    {
      float run = 0.f;
#pragma unroll
      for (int i = 0; i < 16; ++i) {
        const float f = lb + (1.f - lb) * sigmoid_(kk[i]);
        run += __logf(f);
        bc[i] = run;
        kk[i] = 1.f - f;
      }
    }
    const float bmid = bc[7], bend = bc[15];
    gS[lane] = __expf(bend);
    {
      u32x4 p0, p1;
      p0.x = pack2(kk[0] * __expf(bend - bc[0]), kk[1] * __expf(bend - bc[1]));
      p0.y = pack2(kk[2] * __expf(bend - bc[2]), kk[3] * __expf(bend - bc[3]));
      p0.z = pack2(kk[4] * __expf(bend - bc[4]), kk[5] * __expf(bend - bc[5]));
      p0.w = pack2(kk[6] * __expf(bend - bc[6]), kk[7] * __expf(bend - bc[7]));
      p1.x = pack2(kk[8] * __expf(bend - bc[8]), kk[9] * __expf(bend - bc[9]));
      p1.y = pack2(kk[10] * __expf(bend - bc[10]), kk[11] * __expf(bend - bc[11]));
      p1.z = pack2(kk[12] * __expf(bend - bc[12]), kk[13] * __expf(bend - bc[13]));
      p1.w = pack2(kk[14] * __expf(bend - bc[14]), kk[15]);
      *(u32x4*)(kT + lane * 16) = p0;
      *(u32x4*)(kT + lane * 16 + 8) = p1;
      p0.x = pack2(vv[0], vv[1]); p0.y = pack2(vv[2], vv[3]); p0.z = pack2(vv[4], vv[5]); p0.w = pack2(vv[6], vv[7]);
      p1.x = pack2(vv[8], vv[9]); p1.y = pack2(vv[10], vv[11]); p1.z = pack2(vv[12], vv[13]); p1.w = pack2(vv[14], vv[15]);
      *(u32x4*)(vT + lane * 16) = p0;
      *(u32x4*)(vT + lane * 16 + 8) = p1;
    }
    if (OUT) {
#pragma unroll
      for (int i = 0; i < 16; ++i) {
        ka[i * 64 + lane] = f2bf(kk[i] * __expf(fminf(bmid - bc[i], 80.f)));
        const float q = silu_(qq[i]);
        qa[i * 64 + lane] = f2bf(q * __expf(fminf(bc[i] - bmid, 80.f)));
        qs[i * 64 + lane] = f2bf(q * __expf(bc[i]));
      }
    }
  }
  __syncthreads();
  const int tn = w;
  f32x4 S[4];
#pragma unroll
  for (int tm = 0; tm < 4; ++tm)
#pragma unroll
    for (int r = 0; r < 4; ++r) S[tm][r] = OUT ? P.sst[((size_t)su * 64 + tm * 16 + fq * 4 + r) * 64 + tn * 16 + fr] : 0.f;
  for (int sub = 0; sub < 4; ++sub) {
    const char* wl = lds + sub * 10752;
    const bf16_t* qa = (const bf16_t*)wl;
    const bf16_t* qs = qa + 1024;
    const bf16_t* ka = qs + 1024;
    const bf16_t* kT = ka + 1024;
    const bf16_t* vT = kT + 1024;
    const float* gS = (const float*)(vT + 1024);
    const u32x2 t2 = *(const u32x2*)(vT + (tn * 16 + fr) * 16 + fq * 4);
    const bf16x8 vb = __builtin_bit_cast(bf16x8, (u32x4){t2.x, t2.y, 0u, 0u});
    if (OUT) {
      f32x4 at = (f32x4){0.f, 0.f, 0.f, 0.f};
#pragma unroll
      for (int ks = 0; ks < 2; ++ks) {
        const bf16x8 a = *(const bf16x8*)(ka + fr * 64 + ks * 32 + fq * 8);
        const bf16x8 b = *(const bf16x8*)(qa + fr * 64 + ks * 32 + fq * 8);
        at = __builtin_amdgcn_mfma_f32_16x16x32_bf16(a, b, at, 0, 0, 0);
      }
#pragma unroll
      for (int r = 0; r < 4; ++r) if (fq * 4 + r > fr) at[r] = 0.f;
      const bf16x8 pa = __builtin_bit_cast(bf16x8, (u32x4){pack2(at[0], at[1]), pack2(at[2], at[3]), 0u, 0u});
      f32x4 o = (f32x4){0.f, 0.f, 0.f, 0.f};
      o = __builtin_amdgcn_mfma_f32_16x16x32_bf16(pa, vb, o, 0, 0, 0);
#pragma unroll
      for (int c = 0; c < 2; ++c) {
        const u32x2 lo = *(const u32x2*)(qs + fr * 64 + (2 * c) * 16 + fq * 4);
        const u32x2 hi = *(const u32x2*)(qs + fr * 64 + (2 * c + 1) * 16 + fq * 4);
        const bf16x8 qsf = __builtin_bit_cast(bf16x8, (u32x4){lo.x, lo.y, hi.x, hi.y});
        const bf16x8 sb = __builtin_bit_cast(bf16x8, (u32x4){pack2(S[2 * c][0], S[2 * c][1]), pack2(S[2 * c][2], S[2 * c][3]),
                                                               pack2(S[2 * c + 1][0], S[2 * c + 1][1]), pack2(S[2 * c + 1][2], S[2 * c + 1][3])});
        o = __builtin_amdgcn_mfma_f32_16x16x32_bf16(qsf, sb, o, 0, 0, 0);
      }
#pragma unroll
      for (int r = 0; r < 4; ++r) {
        const int tl = sub * 16 + fq * 4 + r, st = d ? 63 - tl : tl;
        P.obuf[((size_t)d * NTOK + n0 + st) * 256 + h * 64 + tn * 16 + fr] = o[r];
      }
    }
#pragma unroll
    for (int tm = 0; tm < 4; ++tm) {
      const f32x4 g4 = *(const f32x4*)(gS + tm * 16 + fq * 4);
      const u32x2 k2 = *(const u32x2*)(kT + (tm * 16 + fr) * 16 + fq * 4);
      const bf16x8 kf = __builtin_bit_cast(bf16x8, (u32x4){k2.x, k2.y, 0u, 0u});
      S[tm] = __builtin_amdgcn_mfma_f32_16x16x32_bf16(kf, vb, S[tm] * g4, 0, 0, 0);
    }
  }
  if (!OUT) {
#pragma unroll
    for (int tm = 0; tm < 4; ++tm)
#pragma unroll
      for (int r = 0; r < 4; ++r) P.kv[((size_t)su * 64 + tm * 16 + fq * 4 + r) * 64 + tn * 16 + fr] = S[tm][r];
    if (w == 0) {
      const float g = ((const float*)(lds + 0 * 10752 + 10240))[lane] * ((const float*)(lds + 1 * 10752 + 10240))[lane] *
                      ((const float*)(lds + 2 * 10752 + 10240))[lane] * ((const float*)(lds + 3 * 10752 + 10240))[lane];
      P.gdec[su * 64 + lane] = g;
    }
  }
}

__device__ void hgrn_c_all(PRef P, int l) {
  const int tid = otid(), w = tid >> 6, lane = tid & 63, sub = lane >> 4, d4 = (lane & 15) * 4;
  const f32x4 gn = *(const f32x4*)(P.hg_norm + l * 64 + d4);
  const int stride = gridDim.x * 16;
  for (int p0 = (blockIdx.x * 4 + w) * 4 + sub; p0 < NTOK * 4; p0 += stride * 4) {
    f32x4 val[4]; u32x2 gb[4];
#pragma unroll
    for (int q = 0; q < 4; ++q) {
      const int pi = p0 + q * stride;
      if (pi < NTOK * 4) {
        const int n = pi >> 2, h = pi & 3;
        val[q] = *(const f32x4*)(P.obuf + (size_t)n * 256 + h * 64 + d4) + *(const f32x4*)(P.obuf + ((size_t)NTOK + n) * 256 + h * 64 + d4);
        gb[q] = *(const u32x2*)(P.z + (size_t)n * 3072 + 1280 + h * 64 + d4);
      } else { val[q] = (f32x4){0.f, 0.f, 0.f, 0.f}; gb[q] = (u32x2){0u, 0u}; }
    }
#pragma unroll
    for (int q = 0; q < 4; ++q) {
      const int pi = p0 + q * stride;
      float ss = val[q][0] * val[q][0] + val[q][1] * val[q][1] + val[q][2] * val[q][2] + val[q][3] * val[q][3];
      ss += __shfl_xor(ss, 1); ss += __shfl_xor(ss, 2); ss += __shfl_xor(ss, 4); ss += __shfl_xor(ss, 8);
      if (pi < NTOK * 4) {
        const int n = pi >> 2, h = pi & 3;
        const float rs = rsqrtf(ss * (1.f / 64.f) + 1e-6f);
        const float g0 = bf2f((bf16_t)(gb[q].x & 0xffff)), g1 = bf2f((bf16_t)(gb[q].x >> 16)), g2 = bf2f((bf16_t)(gb[q].y & 0xffff)), g3 = bf2f((bf16_t)(gb[q].y >> 16));
        uint2 o;
        o.x = pack2(val[q][0] * rs * gn[0] * silu_(g0), val[q][1] * rs * gn[1] * silu_(g1));
        o.y = pack2(val[q][2] * rs * gn[2] * silu_(g2), val[q][3] * rs * gn[3] * silu_(g3));
        *(uint2*)(P.mix + blk_off(n, 256 + h * 64 + d4, 1024)) = o;
      }
    }
  }
}

__device__ void carry_phase(PRef P, int l) {
  const size_t gtid = (size_t)blockIdx.x * 256 + otid(), gsz = (size_t)gridDim.x * 256;
  for (size_t e = gtid; e < (size_t)18 * 4 * 2 * 4096; e += gsz) {
    const int dv = (int)(e & 63), dk = (int)((e >> 6) & 63), d = (int)((e >> 12) & 1), h = (int)((e >> 13) & 3), bb = (int)(e >> 15);
    int mcb, nc; float S;
    if (bb < 16) { mcb = bb * 4; nc = 4; S = 0.f; }
    else { mcb = 64 + (bb - 16) * 16; nc = 16; S = P.state_hgrn[((((size_t)((bb - 16) * 2 + l) * 2 + d) * 4 + h) * 64 + dk) * 64 + dv]; }
    for (int c0 = 0; c0 < nc; c0 += 4) {
      float gq[4], kq[4];
#pragma unroll
      for (int q = 0; q < 4; ++q) {
        const int cc = c0 + q, c = d ? nc - 1 - cc : cc;
        const size_t u = (size_t)((mcb + c) * 4 + h) * 2 + d;
        gq[q] = P.gdec[u * 64 + dk]; kq[q] = P.kv[(u * 64 + dk) * 64 + dv];
      }
#pragma unroll
      for (int q = 0; q < 4; ++q) {
        const int cc = c0 + q, c = d ? nc - 1 - cc : cc;
        const size_t u = (size_t)((mcb + c) * 4 + h) * 2 + d;
        P.sst[(u * 64 + dk) * 64 + dv] = S;
        S = gq[q] * S + kq[q];
      }
    }
    if (bb < 16) P.out[OUT_HG + ((((size_t)(bb * 2 + l) * 2 + d) * 4 + h) * 64 + dk) * 64 + dv] = S;
  }
  for (size_t e = gtid; e < (size_t)18 * 16 * 2 * 64; e += gsz) {
    const int p = (int)(e & 63), d = (int)((e >> 6) & 1), g = (int)((e >> 7) & 15), bb = (int)(e >> 11);
    const int ldg = (l * 2 + d) * 16 + g;
    int cb, nc; float sr, si;
    if (bb < 16) { cb = bb * 8; nc = 8; sr = 0.f; si = 0.f; }
    else {
      cb = 128 + (bb - 16) * 32; nc = 32;
      const float* sp = P.state_s5 + (((((size_t)((bb - 16) * 2 + l) * 2 + d) * 16 + g) * 64 + p) * 2);
      sr = sp[0]; si = sp[1];
    }
    const float2 aT = P.apow[((size_t)ldg * 64 + p) * 33 + 32];
    for (int c0 = 0; c0 < nc; c0 += 8) {
      f32x2 eq[8];
#pragma unroll
      for (int q = 0; q < 8; ++q) {
        const int cc = c0 + q, c = d ? nc - 1 - cc : cc;
        eq[q] = *(const f32x2*)(P.E + ((size_t)(g * 192 + cb + c)) * 256 + d * 128 + p * 2);
      }
#pragma unroll
      for (int q = 0; q < 8; ++q) {
        const int cc = c0 + q, c = d ? nc - 1 - cc : cc;
        *(unsigned*)(P.bts5 + (size_t)g * 256 * 768 + blk_off(cb + c, 512 + d * 128 + p * 2, 768)) = pack2(sr, si);
        const float nr = aT.x * sr - aT.y * si + eq[q][0], ni = aT.x * si + aT.y * sr + eq[q][1];
        sr = nr; si = ni;
      }
    }
    if (bb < 16) {
      const float* ur = P.uedge + (size_t)(bb * 2 + d) * 256 + g * 16;
      float fr_ = 0.f, fi_ = 0.f;
#pragma unroll
      for (int hh = 0; hh < 16; ++hh) {
        const float2 bv = P.bbar[((size_t)ldg * 64 + p) * 16 + hh];
        fr_ += ur[hh] * bv.x; fi_ += ur[hh] * bv.y;
      }
      float* op = P.out + OUT_S5 + (((((size_t)(bb * 2 + l) * 2 + d) * 16 + g) * 64 + p) * 2);
      op[0] = fr_; op[1] = fi_;
    }
  }
}

__device__ __forceinline__ int snake_unit(int pass, int G) { return pass * G + ((pass & 1) ? (G - 1 - (int)blockIdx.x) : (int)blockIdx.x); }
__device__ void mixa_phase(PRef P, int l, char* lds) {
  const int G = gridDim.x, bid = blockIdx.x;
  for (int pass = 0; pass < 3 || (G != 768 && pass * G < 1600); ++pass) {
    int u;
    if (G == 768) {
      if (bid < 256) u = (pass == 0) ? bid : -1;
      else {
        const int j = bid - 256;
        if (pass == 0) u = 1024 + j;
        else if (pass == 1) u = 256 + j;
        else u = (j < 256) ? 256 + 512 + j : (j < 320 ? 1536 + (j - 256) : -1);
      }
    } else {
      u = pass * G + bid;
      if (u >= 1600) u = -1;
    }
    if (u < 0) continue;
    if (u < 256 || (u >= 1024 && u < 1536)) attn_unit(P, l, u < 256 ? u : u - 768, lds);
    else if (u < 1024) hgrn_mfma_unit<false>(P, l, u - 256, lds);
    else s5e_unit(P, l, u - 1536, lds);
  }
}
__device__ void mixb_phase(PRef P, int l, char* lds) {
  for (int u = blockIdx.x; u < 768 + 256; u += gridDim.x) {
    if (u < 768) hgrn_mfma_unit<true>(P, l, u, lds);
    else s5y_unit(P, l, u - 768, lds);
  }
}
__device__ void gluc_phase(PRef P, int l, char* lds) {
  for (int u = blockIdx.x; u < 96; u += gridDim.x) glu_unit(P, l, u, lds);
  hgrn_c_all(P, l);
}

#define XB_TMO      128
#define XB_XCNT(j)  (256  + 64 * (j))
#define XB_XSUB(j)  (1280 + 64 * (j))
#define XB_XGEN(j)  (2304 + 64 * (j))
#define XB_TOP      3328
#define XB_TOPGEN   3392
#define XCD_BAR_WORDS 3456
#define XB_SPIN_CAP (1u << 18)
#define LAS __attribute__((address_space(3)))
__device__ __forceinline__ unsigned xb_ld(unsigned* p)              { return __hip_atomic_load(p, __ATOMIC_RELAXED, __HIP_MEMORY_SCOPE_AGENT); }
__device__ __forceinline__ unsigned xb_add(unsigned* p, unsigned v) { return __hip_atomic_fetch_add(p, v, __ATOMIC_RELAXED, __HIP_MEMORY_SCOPE_AGENT); }
__device__ __forceinline__ unsigned xb_xcc_id() { return (unsigned)__builtin_amdgcn_s_getreg((3 << 11) | 20) & 0xFu; }
#define XB_SPIN(cond, bar) do { unsigned _sp = 0; while (cond) { __builtin_amdgcn_s_sleep(1); \
    if ((++_sp & 255u) == 0u) { if (xb_ld(&(bar)[XB_TMO])) break; if (_sp > XB_SPIN_CAP) { atomicAdd(&(bar)[XB_TMO], 1u); break; } } } } while (0)
struct XcdBarrier { unsigned* bar; unsigned x; volatile LAS unsigned* st; };
__device__ __forceinline__ XcdBarrier xcd_barrier_post(unsigned* bar, volatile LAS unsigned* st) {
    XcdBarrier b; b.bar = bar; b.x = xb_xcc_id(); b.st = st;
    if (threadIdx.x == 0) (void)xb_add(&bar[XB_XCNT(b.x)], 1u);
    return b;
}
__device__ __forceinline__ void xcd_barrier_complete(unsigned* bar, unsigned x, unsigned& nloc, unsigned& nx) {
    const unsigned G = gridDim.x * gridDim.y * gridDim.z;
    unsigned sum, cnt, mine, sp = 0u;
    for (;;) {
        sum = 0u; cnt = 0u; mine = 0u;
#pragma unroll
        for (unsigned j = 0; j < 16; ++j) { const unsigned c = xb_ld(&bar[XB_XCNT(j)]); sum += c; cnt += (c > 0u) ? 1u : 0u; mine = (j == x) ? c : mine; }
        if (sum == G) break;
        __builtin_amdgcn_s_sleep(1);
        if ((++sp & 255u) == 0u) { if (xb_ld(&bar[XB_TMO])) break; if (sp > XB_SPIN_CAP) { atomicAdd(&bar[XB_TMO], 1u); break; } }
    }
    nloc = mine > 0u ? mine : 1u; nx = cnt > 0u ? cnt : 1u;
}
template <bool INV>
__device__ __forceinline__ void xcd_barrier(const XcdBarrier& b) {
    asm volatile("s_waitcnt vmcnt(0)" ::: "memory");
    __syncthreads();
    if (threadIdx.x == 0) {
        unsigned* bar = b.bar;
        __builtin_amdgcn_s_waitcnt(0);
        unsigned nloc = b.st[0], nx = b.st[1];
        if (nloc == 0u) { xcd_barrier_complete(bar, b.x, nloc, nx); b.st[0] = nloc; b.st[1] = nx; }
        const unsigned old = xb_add(&bar[XB_XSUB(b.x)], 1u);
        const unsigned gen = old / nloc;
        if (old + 1u == (gen + 1u) * nloc) {
            __builtin_amdgcn_fence(__ATOMIC_RELEASE, "agent");
            asm volatile("s_waitcnt vmcnt(0)" ::: "memory");
            const unsigned og = xb_add(&bar[XB_TOP], 1u);
            const unsigned tg = og / nx;
            if (og + 1u == (tg + 1u) * nx) xb_add(&bar[XB_TOPGEN], 1u);
            else XB_SPIN(xb_ld(&bar[XB_TOPGEN]) == tg, bar);
            if (INV) __builtin_amdgcn_fence(__ATOMIC_ACQUIRE, "agent");
            xb_add(&bar[XB_XGEN(b.x)], 1u);
            asm volatile("s_waitcnt vmcnt(0)" ::: "memory");
        } else {
            XB_SPIN(xb_ld(&bar[XB_XGEN(b.x)]) == gen, bar);
            if (INV) __builtin_amdgcn_fence(__ATOMIC_ACQUIRE, "agent");
            asm volatile("s_waitcnt vmcnt(0)" ::: "memory");
        }
    }
    __syncthreads();
}

template <int S>
__device__ __forceinline__ void run_step(PRef P, int l, char* lds) {
  if constexpr (S == 0) phase0a(P, lds);
  else if constexpr (S == 1) phase0b(P);
  else if constexpr (S == 2) normmod_phase(P, l, 0);
  else if constexpr (S == 3) win_phase(P, l, lds);
  else if constexpr (S == 4) mixa_phase(P, l, lds);
  else if constexpr (S == 5) carry_phase(P, l);
  else if constexpr (S == 6) mixb_phase(P, l, lds);
  else if constexpr (S == 7) gluc_phase(P, l, lds);
  else if constexpr (S == 8) wout_phase(P, l, lds);
  else if constexpr (S == 9) normmod_phase(P, l, 1);
  else if constexpr (S == 10) mlp1_phase(P, l, lds);
  else if constexpr (S == 11) mlp2_phase(P, l, lds);
  else if constexpr (S == 13) mlp2_phase<true>(P, l, lds);
  else if constexpr (S == 15) mlp1_dummy_phase<true>(P, l, lds);
  else if constexpr (S == 16) mlp1_dummy_phase<false>(P, l, lds);
  else if constexpr (S == 14) wout_phase<true>(P, l, lds);
  else final_phase(P);
}

#if ONE_LAUNCH
__device__ __forceinline__ PPtr kparams() {
  PPtr pp = (PPtr)__builtin_amdgcn_kernarg_segment_ptr();
  asm volatile("" : "+s"(pp));
  return pp;
}
#define RUN(S_, l_) run_step<S_>(*kparams(), l_, lds)
__global__ void __launch_bounds__(256, 3) mega(Params Pv) {
  __shared__ __attribute__((aligned(16))) char lds[45056];
  __shared__ uint4 xb_words;
  if (threadIdx.x == 0) xb_words = make_uint4(0u, 0u, 0u, 0u);
  __syncthreads();
  (void)xcd_barrier_post(kparams()->bar, (volatile LAS unsigned*)&xb_words);
#define GSYNC_(INV_) do { XcdBarrier xb_; xb_.bar = kparams()->bar; xb_.x = xb_xcc_id(); xb_.st = (volatile LAS unsigned*)&xb_words; xcd_barrier<INV_>(xb_); } while (0)
#define GSYNC() GSYNC_(false)
#define GSYNCI() GSYNC_(true)
  RUN(0, 0);
  if (kparams()->use_cg) cg::this_grid().sync();
  GSYNC();
#pragma nounroll
  for (int l = 0; l < 2; ++l) {
    RUN(2, l); GSYNC();
    RUN(3, l); GSYNCI();
    RUN(4, l); GSYNC();
    RUN(5, l); GSYNC();
    RUN(6, l); GSYNC();
    RUN(7, l); GSYNC();
    RUN(8, l); GSYNC();
    RUN(9, l); GSYNC();
    RUN(10, l); GSYNCI();
    RUN(11, l); GSYNC();
  }
  RUN(12, 0);
}
#else
template <int S>
__global__ void __launch_bounds__(256, 2) step_kernel(Params Pv, int l) {
  __shared__ __attribute__((aligned(16))) char lds[45056];
  run_step<S>(*(PPtr)__builtin_amdgcn_kernarg_segment_ptr(), l, lds);
}
#endif

extern "C" void kernel_launch(void* const* d_in, const int* in_sizes, int n_in, void* d_out, int out_size, void* d_ws, size_t ws_size,
                              hipStream_t stream) {
  Params P{};
  const float** pin = (const float**)&P;
  for (int i = 0; i < 30; ++i) pin[i] = (const float*)d_in[i];
  P.out = (float*)d_out;
  char* ws = (char*)d_ws;
  size_t off = 0;
  auto alloc = [&](size_t bytes) { char* p = ws + off; off += (bytes + 255) & ~(size_t)255; return p; };
  P.wt_in = (bf16_t*)alloc((size_t)2 * 3072 * 1024 * 2);
  P.wt_out = (bf16_t*)alloc((size_t)2 * 1024 * 1024 * 2);
  P.wt_m1 = (bf16_t*)alloc((size_t)2 * 4096 * 1024 * 2);
  P.wt_m2 = (bf16_t*)alloc((size_t)2 * 4096 * 1024 * 2);
  P.wt_glu = (bf16_t*)alloc((size_t)2 * 256 * 256 * 2);
  P.adap = (float*)alloc((size_t)2 * 16 * 3 * 6144 * 4);
  P.mod = (float*)alloc((size_t)2 * 3 * 6144 * 4);
  P.uedge = (float*)alloc((size_t)16 * 2 * 256 * 4);
  P.z = (bf16_t*)alloc((size_t)NTOK * 4096 * 2);
  P.hid = P.z;
  P.h = (bf16_t*)alloc((size_t)NTOK * 1024 * 2);
  P.mix = (bf16_t*)alloc((size_t)NTOK * 1024 * 2);
  P.xg = (bf16_t*)alloc((size_t)NTOK * 256 * 2);
  P.ckb = (bf16_t*)alloc((size_t)2 * 2 * 512 * 512 * 2);
  P.cvb = (bf16_t*)alloc((size_t)2 * 2 * 512 * 512 * 2);
  P.apow = (float2*)alloc((size_t)64 * 64 * 33 * 8);
  P.bbar = (float2*)alloc((size_t)64 * 64 * 16 * 8);
  P.ktab = (float*)alloc((size_t)64 * 8192 * 4);
  P.atab = (bf16_t*)alloc((size_t)32 * 512 * 768 * 2);
  P.wtab = (bf16_t*)alloc((size_t)32 * 256 * 512 * 2);
  P.bts5 = (bf16_t*)alloc((size_t)16 * 256 * 768 * 2);
  P.E = (float*)alloc((size_t)16 * 256 * 192 * 4);
  P.kv = (float*)alloc((size_t)768 * 4096 * 4);
  P.gdec = (float*)alloc((size_t)768 * 64 * 4);
  P.sst = (float*)alloc((size_t)768 * 4096 * 4);
  P.obuf = (float*)alloc((size_t)2 * NTOK * 256 * 4);
  P.pbuf = P.kv;
  P.bar = (unsigned*)alloc((size_t)XCD_BAR_WORDS * 4);
  if (off > ws_size) { fprintf(stderr, "workspace too small: need %zu have %zu\n", off, ws_size); return; }

#if ONE_LAUNCH
  static int grid_blocks = 0;
  if (!grid_blocks) {
    int dev = 0, cus = 0, per_cu = 0;
    (void)hipGetDevice(&dev);
    (void)hipDeviceGetAttribute(&cus, hipDeviceAttributeMultiprocessorCount, dev);
    (void)hipOccupancyMaxActiveBlocksPerMultiprocessor(&per_cu, mega, 256, 0);
    if (per_cu < 1) per_cu = 1;
    if (per_cu > 4) per_cu = 4;
    grid_blocks = cus * per_cu;
  }
  (void)hipMemsetAsync(P.bar, 0, (size_t)XCD_BAR_WORDS * 4, stream);
  (void)hipMemsetAsync(P.mod, 0, (size_t)2 * 3 * 6144 * 4, stream);
  void* args[] = {&P};
  hipError_t e = hipLaunchCooperativeKernel((void*)mega, dim3(grid_blocks), dim3(256), args, 0, stream);
  if (e != hipSuccess) fprintf(stderr, "cooperative launch failed: %s (grid %d)\n", hipGetErrorString(e), grid_blocks);
#else
  const int grid_blocks = 512;
  step_kernel<0><<<grid_blocks, 256, 0, stream>>>(P, 0);
  step_kernel<1><<<grid_blocks, 256, 0, stream>>>(P, 0);
  for (int l = 0; l < 2; ++l) {
    step_kernel<2><<<grid_blocks, 256, 0, stream>>>(P, l);
    step_kernel<3><<<grid_blocks, 256, 0, stream>>>(P, l);
    step_kernel<4><<<grid_blocks, 256, 0, stream>>>(P, l);
    step_kernel<5><<<grid_blocks, 256, 0, stream>>>(P, l);
    step_kernel<6><<<grid_blocks, 256, 0, stream>>>(P, l);
    step_kernel<7><<<grid_blocks, 256, 0, stream>>>(P, l);
    step_kernel<8><<<grid_blocks, 256, 0, stream>>>(P, l);
    step_kernel<9><<<grid_blocks, 256, 0, stream>>>(P, l);
    step_kernel<10><<<grid_blocks, 256, 0, stream>>>(P, l);
    step_kernel<11><<<grid_blocks, 256, 0, stream>>>(P, l);
  }
  step_kernel<12><<<grid_blocks, 256, 0, stream>>>(P, 0);
#endif
}
```

```cpp
#include <hip/hip_runtime.h>
#include <hip/hip_cooperative_groups.h>
#include <cstdio>
#include <cstdint>
namespace cg = cooperative_groups;

#ifndef ONE_LAUNCH
#define ONE_LAUNCH 1
#endif

typedef unsigned short bf16_t;
typedef short bf16x8 __attribute__((ext_vector_type(8)));
typedef float f32x4 __attribute__((ext_vector_type(4)));
typedef unsigned u32x4 __attribute__((ext_vector_type(4)));
typedef unsigned u32x2 __attribute__((ext_vector_type(2)));
typedef float f32x2 __attribute__((ext_vector_type(2)));

#define NTOK 6144
#define NCTX 4096
#define NPHASE 23

struct Params {
  const float *x_prompt, *x_sample, *cache_k, *cache_v, *state_s5, *state_hgrn, *c, *c_ctx;
  const float *w_ada, *b_ada, *norm_mix, *norm_mlp, *w_in, *w_out;
  const float *s5_a_re, *s5_a_im, *s5_b_re, *s5_b_im, *s5_c_re, *s5_c_im, *s5_log_dt, *s5_d, *s5_w_glu, *s5_b_glu;
  const float *hg_lb, *hg_norm, *na_rpb, *w_mlp1, *w_mlp2, *norm_final;
  float* out;
  bf16_t *wt_in, *wt_out, *wt_m1, *wt_m2, *wt_glu;
  float *adap, *mod, *uedge;
  bf16_t* z;
  bf16_t *h, *mix, *hid, *xg, *ckb, *cvb;
  float2 *apow, *bbar;
  float* ktab;
  bf16_t *atab, *wtab, *bts5;
  float* E;
  float *kv, *gdec, *sst, *obuf, *pbuf;
  unsigned* bar;
  int use_cg, pad_;
};

typedef const __attribute__((address_space(4))) Params& PRef;
typedef const __attribute__((address_space(4))) Params* PPtr;

#define OUT_CK 6291456
#define OUT_CV 10485760
#define OUT_S5 14680064
#define OUT_HG 14811136

__device__ __forceinline__ int otid() { int t = (int)__builtin_amdgcn_workitem_id_x(); asm volatile("" : "+v"(t)); return t; }
__device__ __forceinline__ bf16_t f2bf(float f) {
  unsigned u = __float_as_uint(f);
  u += 0x7fffu + ((u >> 16) & 1u);
  return (bf16_t)(u >> 16);
}
__device__ __forceinline__ unsigned pack2(float a, float b) { return (unsigned)f2bf(a) | ((unsigned)f2bf(b) << 16); }
__device__ __forceinline__ float bf2f(bf16_t b) { return __uint_as_float(((unsigned)b) << 16); }
__device__ __forceinline__ float sigmoid_(float x) { return 1.f / (1.f + __expf(-x)); }
__device__ __forceinline__ float silu_(float x) { return x * sigmoid_(x); }
__device__ __forceinline__ float gelu_tanh(float y) {
  float t = 0.7978845608028654f * (y + 0.044715f * y * y * y);
  float th = 1.f - 2.f / (__expf(2.f * t) + 1.f);
  return 0.5f * y * (1.f + th);
}
__device__ __forceinline__ float wave_sum(float v) {
#pragma unroll
  for (int o = 32; o > 0; o >>= 1) v += __shfl_xor(v, o);
  return v;
}
__device__ __forceinline__ int variant_of(int n) { return n < NCTX ? 0 : 1 + ((n - NCTX) >> 10); }
__device__ __forceinline__ float lbv(PRef P, int l, int c) {
  if (l == 0) return 0.f;
  float x0 = P.hg_lb[c], x1 = P.hg_lb[256 + c];
  return 1.f / (1.f + __expf(x0 - x1));
}

__device__ __forceinline__ size_t blk_off(int r, int k, int K) {
  return ((size_t)(r >> 7) * (size_t)(K >> 5) + (size_t)(k >> 5)) * 4096 + (size_t)((r & 127) * 32 + (k & 31));
}
template <int NI = 4, bool HOT = false, bool PERM = false, class Epi>
__device__ __forceinline__ void gemm_tile(const bf16_t* __restrict__ A, const bf16_t* __restrict__ B, int nk,
                                          char* lds, Epi epi) {
  const int tid = otid(), lane = tid & 63, w = tid >> 6, wr = w >> 1, wc = w & 1, fr = lane & 15, fq = lane >> 4;
  constexpr int NB = NI / 2;
  f32x4 acc[4][NI];
#pragma unroll
  for (int i = 0; i < 4; ++i)
#pragma unroll
    for (int j = 0; j < NI; ++j) acc[i][j] = (f32x4){0.f, 0.f, 0.f, 0.f};
  u32x4 ra[2], rb[NB];
  const int wsw = (0x1320 >> ((((tid >> 2) >> 2) & 3) * 4)) & 3;
  const int loff0 = (tid >> 2) * 64 + (((tid & 3) ^ wsw) << 4);
  const int rsw = (0x1320 >> (((fr >> 2) & 3) * 4)) & 3;
  const int aoff = (wr * 64 + fr) * 64 + ((fq ^ rsw) << 4);
  const int boff = 8192 + (wc * (16 * NI) + fr) * 64 + ((fq ^ rsw) << 4);
  const bf16_t* Ap = A + tid * 8;
  const bf16_t* Bp = B + tid * 8;
#define GT_LOAD()                                                                          \
  {                                                                                        \
    _Pragma("unroll") for (int i = 0; i < 2; ++i) ra[i] = *(const u32x4*)(Ap + 2048 * i);  \
    _Pragma("unroll") for (int i = 0; i < NB; ++i) rb[i] = *(const u32x4*)(Bp + 2048 * i); \
  }
#define GT_STORE(buf_)                                                                                         \
  {                                                                                                            \
    _Pragma("unroll") for (int i = 0; i < 2; ++i) *(u32x4*)(lds + (buf_) * 16384 + loff0 + 4096 * i) = ra[i];  \
    _Pragma("unroll") for (int i = 0; i < NB; ++i) *(u32x4*)(lds + (buf_) * 16384 + 8192 + loff0 + 4096 * i) = rb[i]; \
  }
  __syncthreads();
  GT_LOAD();
  GT_STORE(0);
  if (nk > 1) { if (!HOT) { Ap += 4096; Bp += 4096; } GT_LOAD(); }
  __syncthreads();
  for (int kt = 0; kt < nk; ++kt) {
    const int cur = kt & 1;
    if (kt + 1 < nk) GT_STORE(cur ^ 1);
    if (kt + 2 < nk) { if (!HOT) { Ap += 4096; Bp += 4096; } GT_LOAD(); }
    __builtin_amdgcn_sched_barrier(0);
    {
      const char* sb = lds + cur * 16384;
      bf16x8 af[4], bfr[NI];
#pragma unroll
      for (int mi = 0; mi < 4; ++mi) af[mi] = *(const bf16x8*)(sb + aoff + 1024 * mi);
#pragma unroll
      for (int ni = 0; ni < NI; ++ni) bfr[ni] = *(const bf16x8*)(sb + boff + 1024 * ni);
#pragma unroll
      for (int mi = 0; mi < 4; ++mi)
#pragma unroll
        for (int ni = 0; ni < NI; ++ni)
          acc[mi][ni] = __builtin_amdgcn_mfma_f32_16x16x32_bf16(bfr[ni], af[mi], acc[mi][ni], 0, 0, 0);
    }
    __syncthreads();
  }
  if constexpr (PERM) {
#pragma unroll
    for (int mi = 0; mi < 4; ++mi)
#pragma unroll
      for (int k = 0; k < NI / 2; ++k) epi(wr * 64 + mi * 16 + fr, wc * (16 * NI) + k * 32 + fq * 8, acc[mi][2 * k], acc[mi][2 * k + 1]);
  } else {
#pragma unroll
    for (int mi = 0; mi < 4; ++mi)
#pragma unroll
      for (int ni = 0; ni < NI; ++ni) epi(wr * 64 + mi * 16 + fr, wc * (16 * NI) + ni * 16 + fq * 4, acc[mi][ni]);
  }
}

__device__ void transpose_tile(const float* __restrict__ src, bf16_t* __restrict__ dst, int K, int N, int t, char* lds) {
  float* T = (float*)lds;
  const int tid = otid();
  const int ntn = N >> 6, kt = t / ntn, nt = t % ntn;
  __syncthreads();
#pragma unroll
  for (int i = 0; i < 4; ++i) {
    const int idx = tid + 256 * i, kr = idx >> 4, n4 = idx & 15;
    const float4 v = *(const float4*)(src + (size_t)(kt * 64 + kr) * N + nt * 64 + n4 * 4);
    T[kr * 65 + n4 * 4 + 0] = v.x; T[kr * 65 + n4 * 4 + 1] = v.y; T[kr * 65 + n4 * 4 + 2] = v.z; T[kr * 65 + n4 * 4 + 3] = v.w;
  }
  __syncthreads();
#pragma unroll
  for (int i = 0; i < 2; ++i) {
    const int idx = tid + 256 * i, n = idx >> 3, kc = idx & 7;
    uint4 o;
    o.x = pack2(T[(kc * 8 + 0) * 65 + n], T[(kc * 8 + 1) * 65 + n]);
    o.y = pack2(T[(kc * 8 + 2) * 65 + n], T[(kc * 8 + 3) * 65 + n]);
    o.z = pack2(T[(kc * 8 + 4) * 65 + n], T[(kc * 8 + 5) * 65 + n]);
    o.w = pack2(T[(kc * 8 + 6) * 65 + n], T[(kc * 8 + 7) * 65 + n]);
    const int cfull = nt * 64 + n, c32 = cfull & 31, rho = ((c32 >> 2) & 1) * 16 + (c32 >> 3) * 4 + (c32 & 3);
    *(uint4*)(dst + blk_off((cfull & ~31) + rho, kt * 64 + kc * 8, K)) = o;
  }
}

__device__ void ada_unit(PRef P, int u, char* lds) {
  float* sv = (float*)lds;
  const int tid = otid();
  const int l = u / 384, r = u % 384, jb = r / 16, ks = r % 16;
  __syncthreads();
  if (tid < 192) {
    const int v = tid >> 6, k = ks * 64 + (tid & 63);
    const float cv = (v == 0) ? P.c_ctx[k] : P.c[(v - 1) * 1024 + k];
    sv[tid] = silu_(cv);
  }
  __syncthreads();
  const int j = jb * 256 + tid;
  const float* wp = P.w_ada + ((size_t)l * 1024 + ks * 64) * 6144 + j;
  float a0 = 0.f, a1 = 0.f, a2 = 0.f;
#pragma unroll 8
  for (int k = 0; k < 64; ++k) {
    const float wv = wp[(size_t)k * 6144];
    a0 += sv[k] * wv; a1 += sv[64 + k] * wv; a2 += sv[128 + k] * wv;
  }
  if (ks == 0) { const float bj = P.b_ada[l * 6144 + j]; a0 += bj; a1 += bj; a2 += bj; }
  float* mp = P.mod + (size_t)(l * 3) * 6144 + j;
  __hip_atomic_fetch_add(mp, a0, __ATOMIC_RELAXED, __HIP_MEMORY_SCOPE_AGENT);
  __hip_atomic_fetch_add(mp + 6144, a1, __ATOMIC_RELAXED, __HIP_MEMORY_SCOPE_AGENT);
  __hip_atomic_fetch_add(mp + 2 * 6144, a2, __ATOMIC_RELAXED, __HIP_MEMORY_SCOPE_AGENT);
}

__device__ void s5pre_unit(PRef P, int u, char* lds) {
  float2* apw = (float2*)lds;
  float2* bb = apw + 64 * 33;
  float2* cc = bb + 64 * 16;
  const int tid = otid();
  const int ldg = u >> 2, part = u & 3;
  __syncthreads();
  {
    const int p = tid & 63, q = tid >> 6;
    const float are = P.s5_a_re[ldg * 64 + p], aim = P.s5_a_im[ldg * 64 + p];
    const float dt = expf(P.s5_log_dt[ldg]);
    for (int k = q; k < 10; k += 4) {
      const int tau = (k < 8) ? part * 8 + k : (k == 8 ? 1 : 32);
      const float mag = expf((float)tau * are * dt);
      const float ang = (float)tau * aim * dt;
      float sn, cs;
      sincosf(ang, &sn, &cs);
      const float2 v = make_float2(mag * cs, mag * sn);
      apw[p * 33 + tau] = v;
      if (k < 8 || (k == 9 && part == 3)) P.apow[((size_t)ldg * 64 + p) * 33 + tau] = v;
    }
  }
  __syncthreads();
  for (int e = tid; e < 1024; e += 256) {
    const int p = e >> 4, hh = e & 15;
    const float are = P.s5_a_re[ldg * 64 + p], aim = P.s5_a_im[ldg * 64 + p];
    const float2 ab = apw[p * 33 + 1];
    const float nr = ab.x - 1.f, ni = ab.y, den = are * are + aim * aim;
    const float cr = (nr * are + ni * aim) / den, ci = (ni * are - nr * aim) / den;
    const float br = P.s5_b_re[((size_t)ldg * 64 + p) * 16 + hh], bi = P.s5_b_im[((size_t)ldg * 64 + p) * 16 + hh];
    const float2 v = make_float2(cr * br - ci * bi, cr * bi + ci * br);
    bb[p * 16 + hh] = v;
    if (part == 0) P.bbar[((size_t)ldg * 64 + p) * 16 + hh] = v;
    const int h2 = e >> 6, p2 = e & 63;
    cc[h2 * 64 + p2] = make_float2(P.s5_c_re[((size_t)ldg * 16 + h2) * 64 + p2], P.s5_c_im[((size_t)ldg * 16 + h2) * 64 + p2]);
  }
  __syncthreads();
  for (int e = tid; e < 2048; e += 256) {
    const int tau = part * 8 + (e >> 8), hh = (e >> 4) & 15, h2 = e & 15;
    float s = 0.f;
    for (int p = 0; p < 64; ++p) {
      const float2 c = cc[hh * 64 + p], a = apw[p * 33 + tau], b = bb[p * 16 + h2];
      const float tr = a.x * b.x - a.y * b.y, ti = a.x * b.y + a.y * b.x;
      s += c.x * tr - c.y * ti;
    }
    P.ktab[(size_t)ldg * 8192 + tau * 256 + (e & 255)] = s;
  }
}

struct TrDesc { const float* src; bf16_t* dst; int K, N, tile; };
__device__ __forceinline__ TrDesc tr_decode(PRef P, int u) {
  TrDesc D;
  if (u < 2048) { const int l = u >> 10; D.src = P.w_mlp1 + (size_t)l * 1024 * 4096; D.dst = P.wt_m1 + (size_t)l * 4096 * 1024; D.K = 1024; D.N = 4096; D.tile = u & 1023; return D; }
  u -= 2048;
  if (u < 2048) { const int l = u >> 10; D.src = P.w_mlp2 + (size_t)l * 4096 * 1024; D.dst = P.wt_m2 + (size_t)l * 1024 * 4096; D.K = 4096; D.N = 1024; D.tile = u & 1023; return D; }
  u -= 2048;
  if (u < 1536) { const int l = u / 768; D.src = P.w_in + (size_t)l * 1024 * 3072; D.dst = P.wt_in + (size_t)l * 3072 * 1024; D.K = 1024; D.N = 3072; D.tile = u % 768; return D; }
  u -= 1536;
  if (u < 512) { const int l = u >> 8; D.src = P.w_out + (size_t)l * 1024 * 1024; D.dst = P.wt_out + (size_t)l * 1024 * 1024; D.K = 1024; D.N = 1024; D.tile = u & 255; return D; }
  u -= 512;
  { const int l = u >> 4; D.src = P.s5_w_glu + (size_t)l * 256 * 256; D.dst = P.wt_glu + (size_t)l * 256 * 256; D.K = 256; D.N = 256; D.tile = u & 15; return D; }
}
#define TR_NTILES 6176
#define TR_LOAD(r_, D_)                                                                                        \
  {                                                                                                            \
    const int ntn_ = (D_).N >> 6, kt_ = (D_).tile / ntn_, nt_ = (D_).tile % ntn_;                              \
    _Pragma("unroll") for (int i = 0; i < 4; ++i) {                                                            \
      const int idx = tid + 256 * i, kr = idx >> 4, n4 = idx & 15;                                             \
      r_[i] = *(const f32x4*)((D_).src + (size_t)(kt_ * 64 + kr) * (D_).N + nt_ * 64 + n4 * 4);               \
    }                                                                                                          \
  }

__device__ void phase0a(PRef P, char* lds) {
  const int tid = otid();
  const int G = gridDim.x;
  for (int u0 = blockIdx.x; u0 < 256 + 768 + 128; u0 += G) {
    int u = u0;
    if (u < 256) { s5pre_unit(P, u, lds); continue; }
    u -= 256;
    if (u < 768) { ada_unit(P, u, lds); continue; }
    u -= 768;
    {
      const int c = u, which = c >> 6;
      const float* src = (which ? P.cache_v : P.cache_k) + (size_t)(c & 63) * 16384;
      bf16_t* dst = (which ? P.cvb : P.ckb) + (size_t)(c & 63) * 16384;
#pragma unroll
      for (int i = 0; i < 8; ++i) {
        const int e = (tid + 256 * i) * 8;
        const f32x4 a = *(const f32x4*)(src + e), b = *(const f32x4*)(src + e + 4);
        u32x4 o; o.x = pack2(a[0], a[1]); o.y = pack2(a[2], a[3]); o.z = pack2(b[0], b[1]); o.w = pack2(b[2], b[3]);
        *(u32x4*)(dst + e) = o;
      }
    }
  }
  float* T = (float*)lds;
  int t = blockIdx.x;
  f32x4 r[4], rn[4];
  TrDesc D = tr_decode(P, t < TR_NTILES ? t : 0), Dn = D;
  if (t < TR_NTILES) TR_LOAD(r, D);
  while (t < TR_NTILES) {
    const int tn = t + G;
    if (tn < TR_NTILES) { Dn = tr_decode(P, tn); TR_LOAD(rn, Dn); }
    __syncthreads();
#pragma unroll
    for (int i = 0; i < 4; ++i) {
      const int idx = tid + 256 * i, kr = idx >> 4, n4 = idx & 15;
      T[kr * 65 + n4 * 4 + 0] = r[i][0]; T[kr * 65 + n4 * 4 + 1] = r[i][1]; T[kr * 65 + n4 * 4 + 2] = r[i][2]; T[kr * 65 + n4 * 4 + 3] = r[i][3];
    }
    __syncthreads();
    {
      const int ntn = D.N >> 6, kt = D.tile / ntn, nt = D.tile % ntn;
#pragma unroll
      for (int i = 0; i < 2; ++i) {
        const int idx = tid + 256 * i, n = idx >> 3, kc = idx & 7;
        u32x4 o;
        o.x = pack2(T[(kc * 8 + 0) * 65 + n], T[(kc * 8 + 1) * 65 + n]);
        o.y = pack2(T[(kc * 8 + 2) * 65 + n], T[(kc * 8 + 3) * 65 + n]);
        o.z = pack2(T[(kc * 8 + 4) * 65 + n], T[(kc * 8 + 5) * 65 + n]);
        o.w = pack2(T[(kc * 8 + 6) * 65 + n], T[(kc * 8 + 7) * 65 + n]);
        const int cfull = nt * 64 + n, c32 = cfull & 31, rho = ((c32 >> 2) & 1) * 16 + (c32 >> 3) * 4 + (c32 & 3);
        *(u32x4*)(D.dst + blk_off((cfull & ~31) + rho, kt * 64 + kc * 8, D.K)) = o;
      }
    }
#pragma unroll
    for (int i = 0; i < 4; ++i) r[i] = rn[i];
    D = Dn;
    t = tn;
  }
}

__device__ void phase0b(PRef P) {
  const size_t gtid = (size_t)blockIdx.x * 256 + otid(), gsz = (size_t)gridDim.x * 256;
}

__device__ void tables_expand(PRef P) {
  const size_t gtid = (size_t)blockIdx.x * 256 + otid(), gsz = (size_t)gridDim.x * 256;
  for (size_t e8 = gtid; e8 < (size_t)2 * 16 * 512 * 96; e8 += gsz) {
    const int k0 = (int)(e8 % 96) * 8;
    const int m = (int)((e8 / 96) % 512);
    const int lg = (int)(e8 / (96 * 512));
    const int l = lg >> 4, g = lg & 15, i = m >> 4, hh = m & 15;
    const int ldg0 = (l * 2 + 0) * 16 + g, ldg1 = (l * 2 + 1) * 16 + g;
    float v[8];
    if (k0 < 512) {
      const int j = k0 >> 4, h2 = k0 & 15;
      f32x4 a0 = (f32x4){0.f, 0.f, 0.f, 0.f}, a1 = a0, b0 = a0, b1 = a0;
      if (j <= i) { const float* kp = P.ktab + (size_t)ldg0 * 8192 + (i - j) * 256 + hh * 16 + h2; a0 = *(const f32x4*)kp; a1 = *(const f32x4*)(kp + 4); }
      if (j >= i) { const float* kp = P.ktab + (size_t)ldg1 * 8192 + (j - i) * 256 + hh * 16 + h2; b0 = *(const f32x4*)kp; b1 = *(const f32x4*)(kp + 4); }
      const float dsk = P.s5_d[l * 256 + g * 16 + hh];
#pragma unroll
      for (int q = 0; q < 4; ++q) { v[q] = a0[q] + b0[q]; v[4 + q] = a1[q] + b1[q]; }
      if (j == i && hh >= h2 && hh < h2 + 8) {
#pragma unroll
        for (int q = 0; q < 8; ++q) if (q == hh - h2) v[q] += dsk;
      }
    } else {
      const int d = (k0 >= 640) ? 1 : 0;
      const int p0 = ((k0 - 512) & 127) >> 1;
      const int ldg = d ? ldg1 : ldg0;
      const int pw = d ? (32 - i) : (i + 1);
      const f32x4 cr = *(const f32x4*)(P.s5_c_re + ((size_t)ldg * 16 + hh) * 64 + p0), ci = *(const f32x4*)(P.s5_c_im + ((size_t)ldg * 16 + hh) * 64 + p0);
      float2 a[4];
#pragma unroll
      for (int q = 0; q < 4; ++q) a[q] = P.apow[((size_t)ldg * 64 + p0 + q) * 33 + pw];
#pragma unroll
      for (int q = 0; q < 4; ++q) { v[2 * q] = cr[q] * a[q].x - ci[q] * a[q].y; v[2 * q + 1] = -(cr[q] * a[q].y + ci[q] * a[q].x); }
    }
    u32x4 o; o.x = pack2(v[0], v[1]); o.y = pack2(v[2], v[3]); o.z = pack2(v[4], v[5]); o.w = pack2(v[6], v[7]);
    *(u32x4*)(P.atab + (size_t)lg * 512 * 768 + blk_off(m, k0, 768)) = o;
  }
  for (size_t e8 = gtid; e8 < (size_t)2 * 16 * 256 * 64; e8 += gsz) {
    const int k0 = (int)(e8 % 64) * 8;
    const int row = (int)((e8 / 64) % 256);
    const int lg = (int)(e8 / (64 * 256));
    const int l = lg >> 4, g = lg & 15;
    const int d = row >> 7, p = (row & 127) >> 1, ri = row & 1;
    const int ldg = (l * 2 + d) * 16 + g;
    const int j = k0 >> 4, h2 = k0 & 15;
    const int pw = d ? j : (31 - j);
    const float2 a = P.apow[((size_t)ldg * 64 + p) * 33 + pw];
    const f32x4* bp = (const f32x4*)(P.bbar + ((size_t)ldg * 64 + p) * 16 + h2);
    const f32x4 b0 = bp[0], b1 = bp[1], b2 = bp[2], b3 = bp[3];
    const float br[8] = {b0[0], b0[2], b1[0], b1[2], b2[0], b2[2], b3[0], b3[2]};
    const float bi[8] = {b0[1], b0[3], b1[1], b1[3], b2[1], b2[3], b3[1], b3[3]};
    float v[8];
#pragma unroll
    for (int q = 0; q < 8; ++q) v[q] = ri ? (a.x * bi[q] + a.y * br[q]) : (a.x * br[q] - a.y * bi[q]);
    u32x4 o; o.x = pack2(v[0], v[1]); o.y = pack2(v[2], v[3]); o.z = pack2(v[4], v[5]); o.w = pack2(v[6], v[7]);
    *(u32x4*)(P.wtab + (size_t)lg * 256 * 512 + blk_off(row, k0, 512)) = o;
  }
}

__device__ void normmod_phase(PRef P, int l, int which) {
  const int lane = otid() & 63, w = otid() >> 6;
  const float* gam = (which == 0 ? P.norm_mix : P.norm_mlp) + l * 1024;
  const bool addp = (which == 0 && l > 0);
  for (int n = blockIdx.x * 4 + w; n < NTOK; n += gridDim.x * 4) {
    float* xr = P.out + (size_t)n * 1024;
    const float* xin = (l == 0 && which == 0) ? (n < NCTX ? P.x_prompt + (size_t)n * 1024 : P.x_sample + (size_t)(n - NCTX) * 1024) : xr;
    const float* md = P.mod + ((size_t)(l * 3 + variant_of(n))) * 6144 + (which == 0 ? 0 : 3072);
    f32x4 v[4];
    float ss = 0.f;
#pragma unroll
    for (int i = 0; i < 4; ++i) {
      const int k = lane * 8 + 512 * (i >> 1) + 4 * (i & 1);
      v[i] = *(const f32x4*)(xin + k);
      if (addp) {
        v[i] = v[i] + *(const f32x4*)(P.pbuf + (size_t)n * 1024 + k);
        *(f32x4*)(xr + k) = v[i];
      }
      ss += v[i][0] * v[i][0] + v[i][1] * v[i][1] + v[i][2] * v[i][2] + v[i][3] * v[i][3];
    }
    f32x4 gq[4], shq[4], scq[4];
#pragma unroll
    for (int i = 0; i < 4; ++i) {
      const int k = lane * 8 + 512 * (i >> 1) + 4 * (i & 1);
      gq[i] = *(const f32x4*)(gam + k); shq[i] = *(const f32x4*)(md + k); scq[i] = *(const f32x4*)(md + 1024 + k);
    }
    ss = wave_sum(ss);
    const float rstd = rsqrtf(ss * (1.f / 1024.f) + 1e-6f);
#pragma unroll
    for (int j = 0; j < 2; ++j) {
      const int k = lane * 8 + 512 * j;
      const f32x4 o0 = v[2 * j] * rstd * gq[2 * j] * (1.f + scq[2 * j]) + shq[2 * j];
      const f32x4 o1 = v[2 * j + 1] * rstd * gq[2 * j + 1] * (1.f + scq[2 * j + 1]) + shq[2 * j + 1];
      u32x4 ov; ov.x = pack2(o0[0], o0[1]); ov.y = pack2(o0[2], o0[3]); ov.z = pack2(o1[0], o1[1]); ov.w = pack2(o1[2], o1[3]);
      *(u32x4*)(P.h + blk_off(n, k, 1024)) = ov;
    }
  }
  if (l == 0 && which == 0) tables_expand(P);
}

__device__ void final_phase(PRef P) {
  const int lane = otid() & 63, w = otid() >> 6;
  for (int n = blockIdx.x * 4 + w; n < NTOK; n += gridDim.x * 4) {
    float* xr = P.out + (size_t)n * 1024;
    f32x4 v[4];
    float ss = 0.f;
#pragma unroll
    for (int i = 0; i < 4; ++i) {
      v[i] = *(const f32x4*)(xr + lane * 4 + 256 * i) + *(const f32x4*)(P.pbuf + (size_t)n * 1024 + lane * 4 + 256 * i);
      ss += v[i][0] * v[i][0] + v[i][1] * v[i][1] + v[i][2] * v[i][2] + v[i][3] * v[i][3];
    }
    ss = wave_sum(ss);
    const float rstd = rsqrtf(ss * (1.f / 1024.f) + 1e-6f);
#pragma unroll
    for (int i = 0; i < 4; ++i) {
      const int k = lane * 4 + 256 * i;
      const f32x4 g = *(const f32x4*)(P.norm_final + k);
      *(f32x4*)(xr + k) = v[i] * rstd * g;
    }
  }
}

__device__ void win_phase(PRef P, int l, char* lds) {
  for (int u = blockIdx.x; u < 48 * 24; u += gridDim.x) {
    const int mt = u / 24, nt = u % 24, m0 = mt * 128, n0 = nt * 128;
    gemm_tile<4, false, true>(P.h + blk_off(m0, 0, 1024), P.wt_in + (size_t)l * 3072 * 1024 + blk_off(n0, 0, 1024), 32, lds,
      [&](int rl, int cl, f32x4 v, f32x4 w2) {
        const int n = m0 + rl, c = n0 + cl;
        u32x4 zo; zo.x = pack2(v[0], v[1]); zo.y = pack2(v[2], v[3]); zo.z = pack2(w2[0], w2[1]); zo.w = pack2(w2[2], w2[3]);
        *(u32x4*)(P.z + (size_t)n * 3072 + c) = zo;
        if (c < 256) {
          if (n < NCTX && ((n & 255) == 0 || (n & 255) == 255)) {
            float* ue = P.uedge + (size_t)((n >> 8) * 2 + ((n & 255) ? 1 : 0)) * 256 + c;
            *(f32x4*)ue = v; *(f32x4*)(ue + 4) = w2;
          }
          const int g = c >> 4;
          *(u32x4*)(P.bts5 + (size_t)g * 256 * 768 + blk_off(n >> 5, (n & 31) * 16 + (c & 15), 768)) = zo;
        }
        if (c >= 2048 && n < NCTX) {
          const int b = n >> 8, t = n & 255;
          float* dst = P.out + (c < 2560 ? OUT_CK : OUT_CV) + ((size_t)((b * 2 + l) * 256 + t)) * 512 + ((c - 2048) & 511);
          *(f32x4*)dst = v; *(f32x4*)(dst + 4) = w2;
        }
      });
  }
}

template <bool DUMMY = false>
__device__ void wout_phase(PRef P, int l, char* lds) {
  for (int u = blockIdx.x; u < 48 * 16; u += gridDim.x) {
    const int mt = u / 16, nt = u % 16, m0 = mt * 128, n0 = nt * 64;
    gemm_tile<2, false, true>(P.mix + blk_off(m0, 0, 1024), P.wt_out + (size_t)l * 1024 * 1024 + blk_off(n0, 0, 1024), 32, lds,
      [&](int rl, int cl, f32x4 v, f32x4 w2) {
        const int n = m0 + rl, c = n0 + cl;
        const float* gp = P.mod + ((size_t)(l * 3 + variant_of(n))) * 6144 + 2048 + c;
        f32x4* xp = (f32x4*)((DUMMY ? P.kv : P.out) + (size_t)n * 1024 + c);
        const f32x4* xs = (l == 0) ? (const f32x4*)((n < NCTX ? P.x_prompt + (size_t)n * 1024 : P.x_sample + (size_t)(n - NCTX) * 1024) + c) : xp;
        const f32x4 x0 = xs[0], x1 = xs[1];
        xp[0] = x0 + *(const f32x4*)gp * v; xp[1] = x1 + *(const f32x4*)(gp + 4) * w2;
      });
  }
}

__device__ void mlp1_phase(PRef P, int l, char* lds) {
  for (int u = blockIdx.x; u < 48 * 32; u += gridDim.x) {
    const int mt = u / 32, nt = u % 32, m0 = mt * 128, n0 = nt * 128;
    gemm_tile<4, false, true>(P.h + blk_off(m0, 0, 1024), P.wt_m1 + (size_t)l * 4096 * 1024 + blk_off(n0, 0, 1024), 32, lds,
      [&](int rl, int cl, f32x4 v, f32x4 w2) {
        const int n = m0 + rl, c = n0 + cl;
        const f32x4 z4 = (f32x4){0.f, 0.f, 0.f, 0.f};
        const f32x4 a = __builtin_elementwise_max(v, z4), b = __builtin_elementwise_max(w2, z4);
        const f32x4 aa = a * a, bb = b * b;
        u32x4 o; o.x = pack2(aa[0], aa[1]); o.y = pack2(aa[2], aa[3]); o.z = pack2(bb[0], bb[1]); o.w = pack2(bb[2], bb[3]);
        *(u32x4*)(P.hid + blk_off(n, c, 4096)) = o;
      });
  }
}

template <bool HOT>
__device__ void mlp1_dummy_phase(PRef P, int l, char* lds) {
  for (int u = blockIdx.x; u < 48 * 32; u += gridDim.x) {
    const int mt = u / 32, nt = u % 32, m0 = mt * 128, n0 = nt * 128;
    gemm_tile<4, HOT>(P.h + blk_off(m0, 0, 1024), P.wt_m1 + (size_t)l * 4096 * 1024 + blk_off(n0, 0, 1024), 32, lds,
      [&](int rl, int cl, f32x4 v) {
        if (v[0] == 12345.678f) P.kv[rl * 128 + cl] = v[1];
      });
  }
}

template <bool DUMMY = false>
__device__ void mlp2_phase(PRef P, int l, char* lds) {
  for (int u = blockIdx.x; u < 48 * 8 * 2; u += gridDim.x) {
    const int ks = u & 1, t = u >> 1, mt = t / 8, nt = t % 8, m0 = mt * 128, n0 = nt * 128;
    gemm_tile<4, false, true>(P.hid + blk_off(m0, ks * 2048, 4096), P.wt_m2 + (size_t)l * 1024 * 4096 + blk_off(n0, ks * 2048, 4096), 64, lds,
      [&](int rl, int cl, f32x4 v, f32x4 w2) {
        const int n = m0 + rl, c = n0 + cl;
        const float* gp = P.mod + ((size_t)(l * 3 + variant_of(n))) * 6144 + 5120 + c;
        const f32x4 g0 = *(const f32x4*)gp, g1 = *(const f32x4*)(gp + 4);
        if (ks == 0) {
          f32x4* xp = (f32x4*)((DUMMY ? P.kv : P.out) + (size_t)n * 1024 + c);
          const f32x4 x0 = xp[0], x1 = xp[1];
          xp[0] = x0 + g0 * v; xp[1] = x1 + g1 * w2;
        } else {
          f32x4* pp = (f32x4*)((DUMMY ? P.kv : P.pbuf) + (size_t)n * 1024 + c);
          pp[0] = g0 * v; pp[1] = g1 * w2;
        }
      });
  }
}

__device__ void s5e_unit(PRef P, int l, int u, char* lds) {
  const int g = u >> 2, mt = (u >> 1) & 1, nt = u & 1;
  gemm_tile(P.bts5 + (size_t)g * 256 * 768 + blk_off(nt * 128, 0, 768), P.wtab + (size_t)(l * 16 + g) * 256 * 512 + blk_off(mt * 128, 0, 512), 16, lds,
    [&](int rl, int cl, f32x4 v) {
      const int col = nt * 128 + rl, m = mt * 128 + cl;
      if (col < 192) *(f32x4*)(P.E + ((size_t)(g * 192 + col)) * 256 + m) = v;
    });
}

__device__ void s5y_unit(PRef P, int l, int u, char* lds) {
  const int g = u >> 4, mt = (u >> 1) & 7, nt = u & 1;
  gemm_tile<2>(P.bts5 + (size_t)g * 256 * 768 + blk_off(nt * 128, 0, 768), P.atab + (size_t)(l * 16 + g) * 512 * 768 + blk_off(mt * 64, 0, 768), 24, lds,
    [&](int rl, int cl, f32x4 v) {
      const int col = nt * 128 + rl, m = mt * 64 + cl;
      if (col < 192) {
        const int i = m >> 4, hh = m & 15, n = col * 32 + i;
        uint2 o; o.x = pack2(gelu_tanh(v[0]), gelu_tanh(v[1])); o.y = pack2(gelu_tanh(v[2]), gelu_tanh(v[3]));
        *(uint2*)(P.xg + blk_off(n, g * 16 + hh, 256)) = o;
      }
    });
}

__device__ void glu_unit(PRef P, int l, int u, char* lds) {
  {
    const int mt = u >> 1, nt = u & 1, m0 = mt * 128, n0 = nt * 128;
    gemm_tile<4, false, true>(P.xg + blk_off(m0, 0, 256), P.wt_glu + (size_t)l * 256 * 256 + blk_off(n0, 0, 256), 8, lds,
      [&](int rl, int cl, f32x4 v, f32x4 w2) {
        const int n = m0 + rl, c = n0 + cl;
        const u32x4 xv = *(const u32x4*)(P.xg + blk_off(n, c, 256));
        const float* bp = P.s5_b_glu + l * 256 + c;
        const f32x4 b0 = *(const f32x4*)bp, b1 = *(const f32x4*)(bp + 4);
        u32x4 o;
        o.x = pack2(bf2f((bf16_t)(xv.x & 0xffff)) * sigmoid_(v[0] + b0[0]), bf2f((bf16_t)(xv.x >> 16)) * sigmoid_(v[1] + b0[1]));
        o.y = pack2(bf2f((bf16_t)(xv.y & 0xffff)) * sigmoid_(v[2] + b0[2]), bf2f((bf16_t)(xv.y >> 16)) * sigmoid_(v[3] + b0[3]));
        o.z = pack2(bf2f((bf16_t)(xv.z & 0xffff)) * sigmoid_(w2[0] + b1[0]), bf2f((bf16_t)(xv.z >> 16)) * sigmoid_(w2[1] + b1[1]));
        o.w = pack2(bf2f((bf16_t)(xv.w & 0xffff)) * sigmoid_(w2[2] + b1[2]), bf2f((bf16_t)(xv.w >> 16)) * sigmoid_(w2[3] + b1[3]));
        *(u32x4*)(P.mix + blk_off(n, c, 1024)) = o;
      });
  }
}

__device__ void attn_unit(PRef P, int l, int unit, char* lds) {
  char* Ks = lds;
  bf16_t* Vt = (bf16_t*)(lds + 8192);
  float* rpbS = (float*)(lds + 8192 + 64 * 68 * 2);
  const int tid = otid(), lane = tid & 63, w = tid >> 6, fr = lane & 15, fq = lane >> 4;
  const bool lat = unit < 256;
  int b, h, qrow0, ntiles, r = 0, r_start = 0;
  if (lat) { b = unit >> 7; h = (unit >> 4) & 7; r = unit & 15; qrow0 = NCTX + b * 1024 + r * 64; ntiles = 16; r_start = min(max(r - 4, 0), 8); }
  else { const int v = unit - 256; b = v >> 5; h = (v >> 2) & 7; qrow0 = b * 256 + (v & 3) * 64; ntiles = 4; }
  __syncthreads();
  if (lat) for (int i = tid; i < 465; i += 256) rpbS[i] = P.na_rpb[(size_t)((l * 8 + h) * 15) * 31 + i];
  bf16x8 qf[2];
  {
    const bf16_t* zq = P.z + (size_t)(qrow0 + w * 16 + fr) * 3072 + 1536 + h * 64;
#pragma unroll
    for (int ks = 0; ks < 2; ++ks) {
      const bf16x8 a = *(const bf16x8*)(zq + ks * 32 + fq * 8);
#pragma unroll
      for (int j = 0; j < 8; ++j) qf[ks][j] = (short)f2bf(bf2f((bf16_t)a[j]) * 0.125f);
    }
  }
  float m = -INFINITY, lsum = 0.f;
  f32x4 o[4];
#pragma unroll
  for (int i = 0; i < 4; ++i) o[i] = (f32x4){0.f, 0.f, 0.f, 0.f};
  u32x4 kr[2], vr[2];
#define ATT_LOAD_TILE(t_)                                                                                              \
  {                                                                                                                    \
    const int tt = (t_);                                                                                               \
    const bf16_t* kp; const bf16_t* vp; int ld;                                                                        \
    if (lat && tt < 8) {                            \
      const size_t base = ((size_t)((b * 2 + l) * 512 + tt * 64)) * 512 + h * 64;                                      \
      kp = P.ckb + base; vp = P.cvb + base; ld = 512;                                                                  \
    } else {                                                            \
      const int row0 = lat ? (NCTX + b * 1024 + (r_start + tt - 8) * 64) : (b * 256 + tt * 64);                        \
      kp = P.z + (size_t)row0 * 3072 + 2048 + h * 64; vp = kp + 512; ld = 3072;                                        \
    }                                                                                                                  \
    _Pragma("unroll") for (int i = 0; i < 2; ++i) {                                                                    \
      const int c = tid + 256 * i, key = c >> 3, ch = c & 7;                                                           \
      kr[i] = *(const u32x4*)(kp + (size_t)key * ld + ch * 8);                                                         \
      vr[i] = *(const u32x4*)(vp + (size_t)key * ld + ch * 8);                                                         \
    }                                                                                                                  \
  }
  ATT_LOAD_TILE(0);
  for (int t = 0; t < ntiles; ++t) {
    __syncthreads();
#pragma unroll
    for (int i = 0; i < 2; ++i) {
      const int c = tid + 256 * i, key = c >> 3, ch = c & 7;
      *(u32x4*)(Ks + key * 128 + ((ch ^ ((key >> 1) & 7)) << 4)) = kr[i];
      const u32x4 vb = vr[i];
#pragma unroll
      for (int e = 0; e < 4; ++e) {
        Vt[(ch * 8 + 2 * e) * 68 + key] = (bf16_t)(vb[e] & 0xffffu);
        Vt[(ch * 8 + 2 * e + 1) * 68 + key] = (bf16_t)(vb[e] >> 16);
      }
    }
    __syncthreads();
    if (t + 1 < ntiles) ATT_LOAD_TILE(t + 1);
    __builtin_amdgcn_sched_barrier(0);
    f32x4 s[4];
#pragma unroll
    for (int kt = 0; kt < 4; ++kt) {
      s[kt] = (f32x4){0.f, 0.f, 0.f, 0.f};
      const int key = kt * 16 + fr;
#pragma unroll
      for (int ks = 0; ks < 2; ++ks) {
        const bf16x8 a = *(const bf16x8*)(Ks + key * 128 + (((ks * 4 + fq) ^ ((key >> 1) & 7)) << 4));
        s[kt] = __builtin_amdgcn_mfma_f32_16x16x32_bf16(a, qf[ks], s[kt], 0, 0, 0);
      }
    }
    if (lat && t >= 8) {
      const int dr = r_start + (t - 8) - r + 7;
      const int qc = w * 16 + fr;
      const int cs = min(max(qc - 8, 0), 48);
#pragma unroll
      for (int kt = 0; kt < 4; ++kt)
#pragma unroll
        for (int rr = 0; rr < 4; ++rr) {
          const int kc = kt * 16 + fq * 4 + rr;
          const bool in = (kc >= cs) && (kc < cs + 16);
          const int dc = min(max(kc - qc + 15, 0), 30);
          s[kt][rr] = in ? s[kt][rr] + rpbS[dr * 31 + dc] : -1e30f;
        }
    }
    float mx = -INFINITY;
#pragma unroll
    for (int kt = 0; kt < 4; ++kt)
#pragma unroll
      for (int rr = 0; rr < 4; ++rr) mx = fmaxf(mx, s[kt][rr]);
    mx = fmaxf(mx, __shfl_xor(mx, 16));
    mx = fmaxf(mx, __shfl_xor(mx, 32));
    const float mn = fmaxf(m, mx);
    const float alpha = __expf(m - mn);
    float ps = 0.f;
#pragma unroll
    for (int kt = 0; kt < 4; ++kt)
#pragma unroll
      for (int rr = 0; rr < 4; ++rr) { s[kt][rr] = __expf(s[kt][rr] - mn); ps += s[kt][rr]; }
    ps += __shfl_xor(ps, 16);
    ps += __shfl_xor(ps, 32);
    lsum = lsum * alpha + ps;
    m = mn;
#pragma unroll
    for (int i = 0; i < 4; ++i) o[i] = o[i] * alpha;
#pragma unroll
    for (int c = 0; c < 2; ++c) {
      bf16x8 pb;
      pb[0] = (short)f2bf(s[2 * c][0]); pb[1] = (short)f2bf(s[2 * c][1]); pb[2] = (short)f2bf(s[2 * c][2]); pb[3] = (short)f2bf(s[2 * c][3]);
      pb[4] = (short)f2bf(s[2 * c + 1][0]); pb[5] = (short)f2bf(s[2 * c + 1][1]); pb[6] = (short)f2bf(s[2 * c + 1][2]); pb[7] = (short)f2bf(s[2 * c + 1][3]);
#pragma unroll
      for (int dt = 0; dt < 4; ++dt) {
        const int d = dt * 16 + fr;
        const u32x2 lo = *(const u32x2*)(Vt + d * 68 + (2 * c) * 16 + fq * 4);
        const u32x2 hi = *(const u32x2*)(Vt + d * 68 + (2 * c + 1) * 16 + fq * 4);
        const u32x4 avu = (u32x4){lo.x, lo.y, hi.x, hi.y};
        o[dt] = __builtin_amdgcn_mfma_f32_16x16x32_bf16(__builtin_bit_cast(bf16x8, avu), pb, o[dt], 0, 0, 0);
      }
    }
  }
  const float inv = 1.f / lsum;
#pragma unroll
  for (int dt = 0; dt < 4; ++dt) {
    uint2 ov; ov.x = pack2(o[dt][0] * inv, o[dt][1] * inv); ov.y = pack2(o[dt][2] * inv, o[dt][3] * inv);
    *(uint2*)(P.mix + blk_off(qrow0 + w * 16 + fr, 512 + h * 64 + dt * 16 + fq * 4, 1024)) = ov;
  }
}

__device__ void hgrn_a_unit(PRef P, int l, int unit, char* lds) {
  float* fS = (float*)lds;
  float* vS = fS + 4096;
  const int tid = otid(), dv = tid & 63, q4 = tid >> 6;
  const int mc = unit >> 3, h = (unit >> 1) & 3, d = unit & 1, n0 = mc * 64;
  const int zfcol = (d == 0 ? 512 : 768) + h * 64;
  __syncthreads();
#pragma unroll 4
  for (int e = 0; e < 16; ++e) {
    const int idx = tid + 256 * e, s = idx >> 6, ch = idx & 63;
    const bf16_t* zrow = P.z + (size_t)(n0 + s) * 3072;
    const float lb = lbv(P, l, h * 64 + ch);
    fS[idx] = lb + (1.f - lb) * sigmoid_(bf2f(zrow[zfcol + ch]));
    vS[idx] = bf2f(zrow[1024 + h * 64 + ch]);
  }
  __syncthreads();
  f32x2 S[8];
#pragma unroll
  for (int j = 0; j < 8; ++j) S[j] = (f32x2){0.f, 0.f};
  for (int i = 0; i < 64; ++i) {
    const int s = d ? 63 - i : i;
    const float vv = vS[s * 64 + dv];
    const f32x2 vv2 = (f32x2){vv, vv};
#pragma unroll
    for (int j = 0; j < 8; ++j) {
      const f32x2 fv = *(const f32x2*)(fS + s * 64 + q4 * 16 + 2 * j);
      S[j] = fv * (S[j] - vv2) + vv2;
    }
  }
#pragma unroll
  for (int j = 0; j < 8; ++j) {
    P.kv[((size_t)unit * 64 + q4 * 16 + 2 * j) * 64 + dv] = S[j][0];
    P.kv[((size_t)unit * 64 + q4 * 16 + 2 * j + 1) * 64 + dv] = S[j][1];
  }
  if (tid < 64) {
    float g = 1.f;
    for (int s = 0; s < 64; ++s) g *= fS[s * 64 + tid];
    P.gdec[unit * 64 + tid] = g;
  }
}

__device__ void hgrn_b_unit(PRef P, int l, int unit, char* lds) {
  float* fS = (float*)lds;
  float* qS = fS + 1024;
  float* vS = qS + 1024;
  float* opart = vS + 1024;
  const int tid = otid(), dv = tid & 63, q4 = tid >> 6;
  const int mc = unit >> 3, h = (unit >> 1) & 3, d = unit & 1, n0 = mc * 64;
  f32x2 S[8];
#pragma unroll
  for (int j = 0; j < 8; ++j) {
    S[j][0] = P.sst[((size_t)unit * 64 + q4 * 16 + 2 * j) * 64 + dv];
    S[j][1] = P.sst[((size_t)unit * 64 + q4 * 16 + 2 * j + 1) * 64 + dv];
  }
  const int zfcol = (d == 0 ? 512 : 768) + h * 64;
  float rf[4], rq[4], rv[4], rlb[4];
#pragma unroll
  for (int e = 0; e < 4; ++e) rlb[e] = lbv(P, l, h * 64 + ((tid + 256 * e) & 63));
#define HG_LOAD(sub_)                                                                              \
  _Pragma("unroll") for (int e = 0; e < 4; ++e) {                                                  \
    const int idx = tid + 256 * e, i = idx >> 6, ch = idx & 63, tl = (sub_) * 16 + i, s = d ? 63 - tl : tl; \
    const bf16_t* zrow = P.z + (size_t)(n0 + s) * 3072;                                           \
    rf[e] = bf2f(zrow[zfcol + ch]); rq[e] = bf2f(zrow[256 + h * 64 + ch]); rv[e] = bf2f(zrow[1024 + h * 64 + ch]);  \
  }
  HG_LOAD(0);
  for (int sub = 0; sub < 4; ++sub) {
    __syncthreads();
#pragma unroll
    for (int e = 0; e < 4; ++e) {
      const int idx = tid + 256 * e;
      fS[idx] = rlb[e] + (1.f - rlb[e]) * sigmoid_(rf[e]);
      qS[idx] = silu_(rq[e]);
      vS[idx] = rv[e];
    }
    __syncthreads();
    if (sub + 1 < 4) HG_LOAD(sub + 1);
    __builtin_amdgcn_sched_barrier(0);
    for (int i = 0; i < 16; ++i) {
      f32x2 po = (f32x2){0.f, 0.f};
      const float vv = vS[i * 64 + dv];
      const f32x2 vv2 = (f32x2){vv, vv};
#pragma unroll
      for (int j = 0; j < 8; ++j) {
        const f32x2 fv = *(const f32x2*)(fS + i * 64 + q4 * 16 + 2 * j);
        const f32x2 qv = *(const f32x2*)(qS + i * 64 + q4 * 16 + 2 * j);
        S[j] = fv * (S[j] - vv2) + vv2;
        po = S[j] * qv + po;
      }
      opart[(q4 * 16 + i) * 64 + dv] = po[0] + po[1];
    }
    __syncthreads();
#pragma unroll
    for (int e = 0; e < 4; ++e) {
      const int idx = tid + 256 * e, i = idx >> 6, dvv = idx & 63, tl = sub * 16 + i, s = d ? 63 - tl : tl;
      const float sum = opart[(0 * 16 + i) * 64 + dvv] + opart[(1 * 16 + i) * 64 + dvv] + opart[(2 * 16 + i) * 64 + dvv] + opart[(3 * 16 + i) * 64 + dvv];
      P.obuf[((size_t)d * NTOK + n0 + s) * 256 + h * 64 + dvv] = sum;
    }
  }
}

template <bool OUT>
__device__ void hgrn_mfma_unit(PRef P, int l, int su, char* lds) {
  const int tid = otid(), lane = tid & 63, w = tid >> 6, fr = lane & 15, fq = lane >> 4;
  const int mc = su >> 3, h = (su >> 1) & 3, d = su & 1, n0 = mc * 64;
  const int zfcol = (d == 0 ? 512 : 768) + h * 64;
  __syncthreads();
  {
    const int sub = w;
    char* wl = lds + sub * 10752;
    bf16_t* qa = (bf16_t*)wl;
    bf16_t* qs = qa + 1024;
    bf16_t* ka = qs + 1024;
    bf16_t* kT = ka + 1024;
    bf16_t* vT = kT + 1024;
    float* gS = (float*)(vT + 1024);
    const float lb = lbv(P, l, h * 64 + lane);
    float bc[16], kk[16], vv[16], qq[16];
#pragma unroll
    for (int i = 0; i < 16; ++i) {
      const int tl = sub * 16 + i, st = d ? 63 - tl : tl;
      const bf16_t* zrow = P.z + (size_t)(n0 + st) * 3072;
      kk[i] = bf2f(zrow[zfcol + lane]);
      vv[i] = bf2f(zrow[1024 + h * 64 + lane]);
      if (OUT) qq[i] = bf2f(zrow[256 + h * 64 + lane]);
    }
    {
      float run = 0.f;
#pragma unroll
      for (int i = 0; i < 16; ++i) {
        const float f = lb + (1.f - lb) * sigmoid_(kk[i]);
        run += __logf(f);
        bc[i] = run;
        kk[i] = 1.f - f;
      }
    }
    const float bmid = bc[7], bend = bc[15];
    gS[lane] = __expf(bend);
    {
      u32x4 p0, p1;
      p0.x = pack2(kk[0] * __expf(bend - bc[0]), kk[1] * __expf(bend - bc[1]));
      p0.y = pack2(kk[2] * __expf(bend - bc[2]), kk[3] * __expf(bend - bc[3]));
      p0.z = pack2(kk[4] * __expf(bend - bc[4]), kk[5] * __expf(bend - bc[5]));
      p0.w = pack2(kk[6] * __expf(bend - bc[6]), kk[7] * __expf(bend - bc[7]));
      p1.x = pack2(kk[8] * __expf(bend - bc[8]), kk[9] * __expf(bend - bc[9]));
      p1.y = pack2(kk[10] * __expf(bend - bc[10]), kk[11] * __expf(bend - bc[11]));
      p1.z = pack2(kk[12] * __expf(bend - bc[12]), kk[13] * __expf(bend - bc[13]));
      p1.w = pack2(kk[14] * __expf(bend - bc[14]), kk[15]);
      *(u32x4*)(kT + lane * 16) = p0;
      *(u32x4*)(kT + lane * 16 + 8) = p1;
      p0.x = pack2(vv[0], vv[1]); p0.y = pack2(vv[2], vv[3]); p0.z = pack2(vv[4], vv[5]); p0.w = pack2(vv[6], vv[7]);
      p1.x = pack2(vv[8], vv[9]); p1.y = pack2(vv[10], vv[11]); p1.z = pack2(vv[12], vv[13]); p1.w = pack2(vv[14], vv[15]);
      *(u32x4*)(vT + lane * 16) = p0;
      *(u32x4*)(vT + lane * 16 + 8) = p1;
    }
    if (OUT) {
#pragma unroll
      for (int i = 0; i < 16; ++i) {
        ka[i * 64 + lane] = f2bf(kk[i] * __expf(fminf(bmid - bc[i], 80.f)));
        const float q = silu_(qq[i]);
        qa[i * 64 + lane] = f2bf(q * __expf(fminf(bc[i] - bmid, 80.f)));
        qs[i * 64 + lane] = f2bf(q * __expf(bc[i]));
      }
    }
  }
  __syncthreads();
  const int tn = w;
  f32x4 S[4];
#pragma unroll
  for (int tm = 0; tm < 4; ++tm)
#pragma unroll
    for (int r = 0; r < 4; ++r) S[tm][r] = OUT ? P.sst[((size_t)su * 64 + tm * 16 + fq * 4 + r) * 64 + tn * 16 + fr] : 0.f;
  for (int sub = 0; sub < 4; ++sub) {
    const char* wl = lds + sub * 10752;
    const bf16_t* qa = (const bf16_t*)wl;
    const bf16_t* qs = qa + 1024;
    const bf16_t* ka = qs + 1024;
    const bf16_t* kT = ka + 1024;
    const bf16_t* vT = kT + 1024;
    const float* gS = (const float*)(vT + 1024);
    const u32x2 t2 = *(const u32x2*)(vT + (tn * 16 + fr) * 16 + fq * 4);
    const bf16x8 vb = __builtin_bit_cast(bf16x8, (u32x4){t2.x, t2.y, 0u, 0u});
    if (OUT) {
      f32x4 at = (f32x4){0.f, 0.f, 0.f, 0.f};
#pragma unroll
      for (int ks = 0; ks < 2; ++ks) {
        const bf16x8 a = *(const bf16x8*)(ka + fr * 64 + ks * 32 + fq * 8);
        const bf16x8 b = *(const bf16x8*)(qa + fr * 64 + ks * 32 + fq * 8);
        at = __builtin_amdgcn_mfma_f32_16x16x32_bf16(a, b, at, 0, 0, 0);
      }
#pragma unroll
      for (int r = 0; r < 4; ++r) if (fq * 4 + r > fr) at[r] = 0.f;
      const bf16x8 pa = __builtin_bit_cast(bf16x8, (u32x4){pack2(at[0], at[1]), pack2(at[2], at[3]), 0u, 0u});
      f32x4 o = (f32x4){0.f, 0.f, 0.f, 0.f};
      o = __builtin_amdgcn_mfma_f32_16x16x32_bf16(pa, vb, o, 0, 0, 0);
#pragma unroll
      for (int c = 0; c < 2; ++c) {
        const u32x2 lo = *(const u32x2*)(qs + fr * 64 + (2 * c) * 16 + fq * 4);
        const u32x2 hi = *(const u32x2*)(qs + fr * 64 + (2 * c + 1) * 16 + fq * 4);
        const bf16x8 qsf = __builtin_bit_cast(bf16x8, (u32x4){lo.x, lo.y, hi.x, hi.y});
        const bf16x8 sb = __builtin_bit_cast(bf16x8, (u32x4){pack2(S[2 * c][0], S[2 * c][1]), pack2(S[2 * c][2], S[2 * c][3]),
                                                               pack2(S[2 * c + 1][0], S[2 * c + 1][1]), pack2(S[2 * c + 1][2], S[2 * c + 1][3])});
        o = __builtin_amdgcn_mfma_f32_16x16x32_bf16(qsf, sb, o, 0, 0, 0);
      }
#pragma unroll
      for (int r = 0; r < 4; ++r) {
        const int tl = sub * 16 + fq * 4 + r, st = d ? 63 - tl : tl;
        P.obuf[((size_t)d * NTOK + n0 + st) * 256 + h * 64 + tn * 16 + fr] = o[r];
      }
    }
#pragma unroll
    for (int tm = 0; tm < 4; ++tm) {
      const f32x4 g4 = *(const f32x4*)(gS + tm * 16 + fq * 4);
      const u32x2 k2 = *(const u32x2*)(kT + (tm * 16 + fr) * 16 + fq * 4);
      const bf16x8 kf = __builtin_bit_cast(bf16x8, (u32x4){k2.x, k2.y, 0u, 0u});
      S[tm] = __builtin_amdgcn_mfma_f32_16x16x32_bf16(kf, vb, S[tm] * g4, 0, 0, 0);
    }
  }
  if (!OUT) {
#pragma unroll
    for (int tm = 0; tm < 4; ++tm)
#pragma unroll
      for (int r = 0; r < 4; ++r) P.kv[((size_t)su * 64 + tm * 16 + fq * 4 + r) * 64 + tn * 16 + fr] = S[tm][r];
    if (w == 0) {
      const float g = ((const float*)(lds + 0 * 10752 + 10240))[lane] * ((const float*)(lds + 1 * 10752 + 10240))[lane] *
                      ((const float*)(lds + 2 * 10752 + 10240))[lane] * ((const float*)(lds + 3 * 10752 + 10240))[lane];
      P.gdec[su * 64 + lane] = g;
    }
  }
}

__device__ void hgrn_c_all(PRef P, int l) {
  const int tid = otid(), w = tid >> 6, lane = tid & 63, sub = lane >> 4, d4 = (lane & 15) * 4;
  const f32x4 gn = *(const f32x4*)(P.hg_norm + l * 64 + d4);
  const int stride = gridDim.x * 16;
  for (int p0 = (blockIdx.x * 4 + w) * 4 + sub; p0 < NTOK * 4; p0 += stride * 4) {
    f32x4 val[4]; u32x2 gb[4];
#pragma unroll
    for (int q = 0; q < 4; ++q) {
      const int pi = p0 + q * stride;
      if (pi < NTOK * 4) {
        const int n = pi >> 2, h = pi & 3;
        val[q] = *(const f32x4*)(P.obuf + (size_t)n * 256 + h * 64 + d4) + *(const f32x4*)(P.obuf + ((size_t)NTOK + n) * 256 + h * 64 + d4);
        gb[q] = *(const u32x2*)(P.z + (size_t)n * 3072 + 1280 + h * 64 + d4);
      } else { val[q] = (f32x4){0.f, 0.f, 0.f, 0.f}; gb[q] = (u32x2){0u, 0u}; }
    }
#pragma unroll
    for (int q = 0; q < 4; ++q) {
      const int pi = p0 + q * stride;
      float ss = val[q][0] * val[q][0] + val[q][1] * val[q][1] + val[q][2] * val[q][2] + val[q][3] * val[q][3];
      ss += __shfl_xor(ss, 1); ss += __shfl_xor(ss, 2); ss += __shfl_xor(ss, 4); ss += __shfl_xor(ss, 8);
      if (pi < NTOK * 4) {
        const int n = pi >> 2, h = pi & 3;
        const float rs = rsqrtf(ss * (1.f / 64.f) + 1e-6f);
        const float g0 = bf2f((bf16_t)(gb[q].x & 0xffff)), g1 = bf2f((bf16_t)(gb[q].x >> 16)), g2 = bf2f((bf16_t)(gb[q].y & 0xffff)), g3 = bf2f((bf16_t)(gb[q].y >> 16));
        uint2 o;
        o.x = pack2(val[q][0] * rs * gn[0] * silu_(g0), val[q][1] * rs * gn[1] * silu_(g1));
        o.y = pack2(val[q][2] * rs * gn[2] * silu_(g2), val[q][3] * rs * gn[3] * silu_(g3));
        *(uint2*)(P.mix + blk_off(n, 256 + h * 64 + d4, 1024)) = o;
      }
    }
  }
}

__device__ void carry_phase(PRef P, int l) {
  const size_t gtid = (size_t)blockIdx.x * 256 + otid(), gsz = (size_t)gridDim.x * 256;
  for (size_t e = gtid; e < (size_t)18 * 4 * 2 * 4096; e += gsz) {
    const int dv = (int)(e & 63), dk = (int)((e >> 6) & 63), d = (int)((e >> 12) & 1), h = (int)((e >> 13) & 3), bb = (int)(e >> 15);
    int mcb, nc; float S;
    if (bb < 16) { mcb = bb * 4; nc = 4; S = 0.f; }
    else { mcb = 64 + (bb - 16) * 16; nc = 16; S = P.state_hgrn[((((size_t)((bb - 16) * 2 + l) * 2 + d) * 4 + h) * 64 + dk) * 64 + dv]; }
    for (int c0 = 0; c0 < nc; c0 += 4) {
      float gq[4], kq[4];
#pragma unroll
      for (int q = 0; q < 4; ++q) {
        const int cc = c0 + q, c = d ? nc - 1 - cc : cc;
        const size_t u = (size_t)((mcb + c) * 4 + h) * 2 + d;
        gq[q] = P.gdec[u * 64 + dk]; kq[q] = P.kv[(u * 64 + dk) * 64 + dv];
      }
#pragma unroll
      for (int q = 0; q < 4; ++q) {
        const int cc = c0 + q, c = d ? nc - 1 - cc : cc;
        const size_t u = (size_t)((mcb + c) * 4 + h) * 2 + d;
        P.sst[(u * 64 + dk) * 64 + dv] = S;
        S = gq[q] * S + kq[q];
      }
    }
    if (bb < 16) P.out[OUT_HG + ((((size_t)(bb * 2 + l) * 2 + d) * 4 + h) * 64 + dk) * 64 + dv] = S;
  }
  for (size_t e = gtid; e < (size_t)18 * 16 * 2 * 64; e += gsz) {
    const int p = (int)(e & 63), d = (int)((e >> 6) & 1), g = (int)((e >> 7) & 15), bb = (int)(e >> 11);
    const int ldg = (l * 2 + d) * 16 + g;
    int cb, nc; float sr, si;
    if (bb < 16) { cb = bb * 8; nc = 8; sr = 0.f; si = 0.f; }
    else {
      cb = 128 + (bb - 16) * 32; nc = 32;
      const float* sp = P.state_s5 + (((((size_t)((bb - 16) * 2 + l) * 2 + d) * 16 + g) * 64 + p) * 2);
      sr = sp[0]; si = sp[1];
    }
    const float2 aT = P.apow[((size_t)ldg * 64 + p) * 33 + 32];
    for (int c0 = 0; c0 < nc; c0 += 8) {
      f32x2 eq[8];
#pragma unroll
      for (int q = 0; q < 8; ++q) {
        const int cc = c0 + q, c = d ? nc - 1 - cc : cc;
        eq[q] = *(const f32x2*)(P.E + ((size_t)(g * 192 + cb + c)) * 256 + d * 128 + p * 2);
      }
#pragma unroll
      for (int q = 0; q < 8; ++q) {
        const int cc = c0 + q, c = d ? nc - 1 - cc : cc;
        *(unsigned*)(P.bts5 + (size_t)g * 256 * 768 + blk_off(cb + c, 512 + d * 128 + p * 2, 768)) = pack2(sr, si);
        const float nr = aT.x * sr - aT.y * si + eq[q][0], ni = aT.x * si + aT.y * sr + eq[q][1];
        sr = nr; si = ni;
      }
    }
    if (bb < 16) {
      const float* ur = P.uedge + (size_t)(bb * 2 + d) * 256 + g * 16;
      float fr_ = 0.f, fi_ = 0.f;
#pragma unroll
      for (int hh = 0; hh < 16; ++hh) {
        const float2 bv = P.bbar[((size_t)ldg * 64 + p) * 16 + hh];
        fr_ += ur[hh] * bv.x; fi_ += ur[hh] * bv.y;
      }
      float* op = P.out + OUT_S5 + (((((size_t)(bb * 2 + l) * 2 + d) * 16 + g) * 64 + p) * 2);
      op[0] = fr_; op[1] = fi_;
    }
  }
}

__device__ __forceinline__ int snake_unit(int pass, int G) { return pass * G + ((pass & 1) ? (G - 1 - (int)blockIdx.x) : (int)blockIdx.x); }
__device__ void mixa_phase(PRef P, int l, char* lds) {
  const int G = gridDim.x, bid = blockIdx.x;
  for (int pass = 0; pass < 3 || (G != 768 && pass * G < 1600); ++pass) {
    int u;
    if (G == 768) {
      if (bid < 256) u = (pass == 0) ? bid : -1;
      else {
        const int j = bid - 256;
        if (pass == 0) u = 1024 + j;
        else if (pass == 1) u = 256 + j;
        else u = (j < 256) ? 256 + 512 + j : (j < 320 ? 1536 + (j - 256) : -1);
      }
    } else {
      u = pass * G + bid;
      if (u >= 1600) u = -1;
    }
    if (u < 0) continue;
    if (u < 256 || (u >= 1024 && u < 1536)) attn_unit(P, l, u < 256 ? u : u - 768, lds);
    else if (u < 1024) hgrn_mfma_unit<false>(P, l, u - 256, lds);
    else s5e_unit(P, l, u - 1536, lds);
  }
}
__device__ void mixb_phase(PRef P, int l, char* lds) {
  for (int u = blockIdx.x; u < 768 + 256; u += gridDim.x) {
    if (u < 768) hgrn_mfma_unit<true>(P, l, u, lds);
    else s5y_unit(P, l, u - 768, lds);
  }
}
__device__ void gluc_phase(PRef P, int l, char* lds) {
  for (int u = blockIdx.x; u < 96; u += gridDim.x) glu_unit(P, l, u, lds);
  hgrn_c_all(P, l);
}

#define XB_TMO      128
#define XB_XCNT(j)  (256  + 64 * (j))
#define XB_XSUB(j)  (1280 + 64 * (j))
#define XB_XGEN(j)  (2304 + 64 * (j))
#define XB_TOP      3328
#define XB_TOPGEN   3392
#define XCD_BAR_WORDS 3456
#define XB_SPIN_CAP (1u << 18)
#define LAS __attribute__((address_space(3)))
__device__ __forceinline__ unsigned xb_ld(unsigned* p)              { return __hip_atomic_load(p, __ATOMIC_RELAXED, __HIP_MEMORY_SCOPE_AGENT); }
__device__ __forceinline__ unsigned xb_add(unsigned* p, unsigned v) { return __hip_atomic_fetch_add(p, v, __ATOMIC_RELAXED, __HIP_MEMORY_SCOPE_AGENT); }
__device__ __forceinline__ unsigned xb_xcc_id() { return (unsigned)__builtin_amdgcn_s_getreg((3 << 11) | 20) & 0xFu; }
#define XB_SPIN(cond, bar) do { unsigned _sp = 0; while (cond) { __builtin_amdgcn_s_sleep(1); \
    if ((++_sp & 255u) == 0u) { if (xb_ld(&(bar)[XB_TMO])) break; if (_sp > XB_SPIN_CAP) { atomicAdd(&(bar)[XB_TMO], 1u); break; } } } } while (0)
struct XcdBarrier { unsigned* bar; unsigned x; volatile LAS unsigned* st; };
__device__ __forceinline__ XcdBarrier xcd_barrier_post(unsigned* bar, volatile LAS unsigned* st) {
    XcdBarrier b; b.bar = bar; b.x = xb_xcc_id(); b.st = st;
    if (threadIdx.x == 0) (void)xb_add(&bar[XB_XCNT(b.x)], 1u);
    return b;
}
__device__ __forceinline__ void xcd_barrier_complete(unsigned* bar, unsigned x, unsigned& nloc, unsigned& nx) {
    const unsigned G = gridDim.x * gridDim.y * gridDim.z;
    unsigned sum, cnt, mine, sp = 0u;
    for (;;) {
        sum = 0u; cnt = 0u; mine = 0u;
#pragma unroll
        for (unsigned j = 0; j < 16; ++j) { const unsigned c = xb_ld(&bar[XB_XCNT(j)]); sum += c; cnt += (c > 0u) ? 1u : 0u; mine = (j == x) ? c : mine; }
        if (sum == G) break;
        __builtin_amdgcn_s_sleep(1);
        if ((++sp & 255u) == 0u) { if (xb_ld(&bar[XB_TMO])) break; if (sp > XB_SPIN_CAP) { atomicAdd(&bar[XB_TMO], 1u); break; } }
    }
    nloc = mine > 0u ? mine : 1u; nx = cnt > 0u ? cnt : 1u;
}
template <bool INV>
__device__ __forceinline__ void xcd_barrier(const XcdBarrier& b) {
    asm volatile("s_waitcnt vmcnt(0)" ::: "memory");
    __syncthreads();
    if (threadIdx.x == 0) {
        unsigned* bar = b.bar;
        __builtin_amdgcn_s_waitcnt(0);
        unsigned nloc = b.st[0], nx = b.st[1];
        if (nloc == 0u) { xcd_barrier_complete(bar, b.x, nloc, nx); b.st[0] = nloc; b.st[1] = nx; }
        const unsigned old = xb_add(&bar[XB_XSUB(b.x)], 1u);
        const unsigned gen = old / nloc;
        if (old + 1u == (gen + 1u) * nloc) {
            __builtin_amdgcn_fence(__ATOMIC_RELEASE, "agent");
            asm volatile("s_waitcnt vmcnt(0)" ::: "memory");
            const unsigned og = xb_add(&bar[XB_TOP], 1u);
            const unsigned tg = og / nx;
            if (og + 1u == (tg + 1u) * nx) xb_add(&bar[XB_TOPGEN], 1u);
            else XB_SPIN(xb_ld(&bar[XB_TOPGEN]) == tg, bar);
            if (INV) __builtin_amdgcn_fence(__ATOMIC_ACQUIRE, "agent");
            xb_add(&bar[XB_XGEN(b.x)], 1u);
            asm volatile("s_waitcnt vmcnt(0)" ::: "memory");
        } else {
            XB_SPIN(xb_ld(&bar[XB_XGEN(b.x)]) == gen, bar);
            if (INV) __builtin_amdgcn_fence(__ATOMIC_ACQUIRE, "agent");
            asm volatile("s_waitcnt vmcnt(0)" ::: "memory");
        }
    }
    __syncthreads();
}

template <int S>
__device__ __forceinline__ void run_step(PRef P, int l, char* lds) {
  if constexpr (S == 0) phase0a(P, lds);
  else if constexpr (S == 1) phase0b(P);
  else if constexpr (S == 2) normmod_phase(P, l, 0);
  else if constexpr (S == 3) win_phase(P, l, lds);
  else if constexpr (S == 4) mixa_phase(P, l, lds);
  else if constexpr (S == 5) carry_phase(P, l);
  else if constexpr (S == 6) mixb_phase(P, l, lds);
  else if constexpr (S == 7) gluc_phase(P, l, lds);
  else if constexpr (S == 8) wout_phase(P, l, lds);
  else if constexpr (S == 9) normmod_phase(P, l, 1);
  else if constexpr (S == 10) mlp1_phase(P, l, lds);
  else if constexpr (S == 11) mlp2_phase(P, l, lds);
  else if constexpr (S == 13) mlp2_phase<true>(P, l, lds);
  else if constexpr (S == 15) mlp1_dummy_phase<true>(P, l, lds);
  else if constexpr (S == 16) mlp1_dummy_phase<false>(P, l, lds);
  else if constexpr (S == 14) wout_phase<true>(P, l, lds);
  else final_phase(P);
}

#if ONE_LAUNCH
__device__ __forceinline__ PPtr kparams() {
  PPtr pp = (PPtr)__builtin_amdgcn_kernarg_segment_ptr();
  asm volatile("" : "+s"(pp));
  return pp;
}
#define RUN(S_, l_) run_step<S_>(*kparams(), l_, lds)
__global__ void __launch_bounds__(256, 3) mega(Params Pv) {
  __shared__ __attribute__((aligned(16))) char lds[45056];
  __shared__ uint4 xb_words;
  if (threadIdx.x == 0) xb_words = make_uint4(0u, 0u, 0u, 0u);
  __syncthreads();
  (void)xcd_barrier_post(kparams()->bar, (volatile LAS unsigned*)&xb_words);
#define GSYNC_(INV_) do { XcdBarrier xb_; xb_.bar = kparams()->bar; xb_.x = xb_xcc_id(); xb_.st = (volatile LAS unsigned*)&xb_words; xcd_barrier<INV_>(xb_); } while (0)
#define GSYNC() GSYNC_(false)
#define GSYNCI() GSYNC_(true)
  RUN(0, 0);
  if (kparams()->use_cg) cg::this_grid().sync();
  GSYNC();
#pragma nounroll
  for (int l = 0; l < 2; ++l) {
    RUN(2, l); GSYNC();
    RUN(3, l); GSYNCI();
    RUN(4, l); GSYNC();
    RUN(5, l); GSYNC();
    RUN(6, l); GSYNC();
    RUN(7, l); GSYNC();
    RUN(8, l); GSYNC();
    RUN(9, l); GSYNC();
    RUN(10, l); GSYNCI();
    RUN(11, l); GSYNC();
  }
  RUN(12, 0);
}
#else
template <int S>
__global__ void __launch_bounds__(256, 2) step_kernel(Params Pv, int l) {
  __shared__ __attribute__((aligned(16))) char lds[45056];
  run_step<S>(*(PPtr)__builtin_amdgcn_kernarg_segment_ptr(), l, lds);
}
#endif

extern "C" void kernel_launch(void* const* d_in, const int* in_sizes, int n_in, void* d_out, int out_size, void* d_ws, size_t ws_size,
                              hipStream_t stream) {
  Params P{};
  const float** pin = (const float**)&P;
  for (int i = 0; i < 30; ++i) pin[i] = (const float*)d_in[i];
  P.out = (float*)d_out;
  char* ws = (char*)d_ws;
  size_t off = 0;
  auto alloc = [&](size_t bytes) { char* p = ws + off; off += (bytes + 255) & ~(size_t)255; return p; };
  P.wt_in = (bf16_t*)alloc((size_t)2 * 3072 * 1024 * 2);
  P.wt_out = (bf16_t*)alloc((size_t)2 * 1024 * 1024 * 2);
  P.wt_m1 = (bf16_t*)alloc((size_t)2 * 4096 * 1024 * 2);
  P.wt_m2 = (bf16_t*)alloc((size_t)2 * 4096 * 1024 * 2);
  P.wt_glu = (bf16_t*)alloc((size_t)2 * 256 * 256 * 2);
  P.adap = (float*)alloc((size_t)2 * 16 * 3 * 6144 * 4);
  P.uedge = (float*)alloc((size_t)16 * 2 * 256 * 4);
  P.z = (bf16_t*)alloc((size_t)NTOK * 4096 * 2);
  P.hid = P.z;
  P.h = (bf16_t*)alloc((size_t)NTOK * 1024 * 2);
  P.mix = (bf16_t*)alloc((size_t)NTOK * 1024 * 2);
  P.xg = (bf16_t*)alloc((size_t)NTOK * 256 * 2);
  P.ckb = (bf16_t*)alloc((size_t)2 * 2 * 512 * 512 * 2);
  P.cvb = (bf16_t*)alloc((size_t)2 * 2 * 512 * 512 * 2);
  P.apow = (float2*)alloc((size_t)64 * 64 * 33 * 8);
  P.bbar = (float2*)alloc((size_t)64 * 64 * 16 * 8);
  P.ktab = (float*)alloc((size_t)64 * 8192 * 4);
  P.atab = (bf16_t*)alloc((size_t)32 * 512 * 768 * 2);
  P.wtab = (bf16_t*)alloc((size_t)32 * 256 * 512 * 2);
  P.bts5 = (bf16_t*)alloc((size_t)16 * 256 * 768 * 2);
  P.E = (float*)alloc((size_t)16 * 256 * 192 * 4);
  P.kv = (float*)alloc((size_t)768 * 4096 * 4);
  P.gdec = (float*)alloc((size_t)768 * 64 * 4);
  P.sst = (float*)alloc((size_t)768 * 4096 * 4);
  P.obuf = (float*)alloc((size_t)2 * NTOK * 256 * 4);
  P.pbuf = P.kv;
  P.bar = (unsigned*)alloc((size_t)XCD_BAR_WORDS * 4);
  P.mod = (float*)alloc((size_t)2 * 3 * 6144 * 4);
  const size_t zero_bytes = (size_t)((char*)P.mod - (char*)P.bar) + (size_t)2 * 3 * 6144 * 4;
  if (off > ws_size) { fprintf(stderr, "workspace too small: need %zu have %zu\n", off, ws_size); return; }

#if ONE_LAUNCH
  static int grid_blocks = 0;
  if (!grid_blocks) {
    int dev = 0, cus = 0, per_cu = 0;
    (void)hipGetDevice(&dev);
    (void)hipDeviceGetAttribute(&cus, hipDeviceAttributeMultiprocessorCount, dev);
    (void)hipOccupancyMaxActiveBlocksPerMultiprocessor(&per_cu, mega, 256, 0);
    if (per_cu < 1) per_cu = 1;
    if (per_cu > 4) per_cu = 4;
    grid_blocks = cus * per_cu;
  }
  (void)hipMemsetAsync(P.bar, 0, zero_bytes, stream);
  void* args[] = {&P};
  hipError_t e = hipLaunchCooperativeKernel((void*)mega, dim3(grid_blocks), dim3(256), args, 0, stream);
  if (e != hipSuccess) fprintf(stderr, "cooperative launch failed: %s (grid %d)\n", hipGetErrorString(e), grid_blocks);
#else
  const int grid_blocks = 512;
  step_kernel<0><<<grid_blocks, 256, 0, stream>>>(P, 0);
  step_kernel<1><<<grid_blocks, 256, 0, stream>>>(P, 0);
  for (int l = 0; l < 2; ++l) {
    step_kernel<2><<<grid_blocks, 256, 0, stream>>>(P, l);
    step_kernel<3><<<grid_blocks, 256, 0, stream>>>(P, l);
    step_kernel<4><<<grid_blocks, 256, 0, stream>>>(P, l);
    step_kernel<5><<<grid_blocks, 256, 0, stream>>>(P, l);
    step_kernel<6><<<grid_blocks, 256, 0, stream>>>(P, l);
    step_kernel<7><<<grid_blocks, 256, 0, stream>>>(P, l);
    step_kernel<8><<<grid_blocks, 256, 0, stream>>>(P, l);
    step_kernel<9><<<grid_blocks, 256, 0, stream>>>(P, l);
    step_kernel<10><<<grid_blocks, 256, 0, stream>>>(P, l);
    step_kernel<11><<<grid_blocks, 256, 0, stream>>>(P, l);
  }
  step_kernel<12><<<grid_blocks, 256, 0, stream>>>(P, 0);
#endif
}
```

```cpp
#include <hip/hip_runtime.h>
#include <hip/hip_cooperative_groups.h>
#include <cstdio>
#include <cstdint>
namespace cg = cooperative_groups;

#ifndef ONE_LAUNCH
#define ONE_LAUNCH 1
#endif

typedef unsigned short bf16_t;
typedef short bf16x8 __attribute__((ext_vector_type(8)));
typedef float f32x4 __attribute__((ext_vector_type(4)));
typedef unsigned u32x4 __attribute__((ext_vector_type(4)));
typedef unsigned u32x2 __attribute__((ext_vector_type(2)));
typedef float f32x2 __attribute__((ext_vector_type(2)));

#define NTOK 6144
#define NCTX 4096
#define NPHASE 23

struct Params {
  const float *x_prompt, *x_sample, *cache_k, *cache_v, *state_s5, *state_hgrn, *c, *c_ctx;
  const float *w_ada, *b_ada, *norm_mix, *norm_mlp, *w_in, *w_out;
  const float *s5_a_re, *s5_a_im, *s5_b_re, *s5_b_im, *s5_c_re, *s5_c_im, *s5_log_dt, *s5_d, *s5_w_glu, *s5_b_glu;
  const float *hg_lb, *hg_norm, *na_rpb, *w_mlp1, *w_mlp2, *norm_final;
  float* out;
  bf16_t *wt_in, *wt_out, *wt_m1, *wt_m2, *wt_glu;
  float *adap, *mod, *uedge;
  bf16_t* z;
  bf16_t *h, *mix, *hid, *xg, *ckb, *cvb;
  float2 *apow, *bbar;
  float* ktab;
  bf16_t *atab, *wtab, *bts5;
  float* E;
  float *kv, *gdec, *sst, *obuf, *pbuf;
  unsigned* bar;
  int use_cg, pad_;
};

typedef const __attribute__((address_space(4))) Params& PRef;
typedef const __attribute__((address_space(4))) Params* PPtr;

#define OUT_CK 6291456
#define OUT_CV 10485760
#define OUT_S5 14680064
#define OUT_HG 14811136

__device__ __forceinline__ int otid() { int t = (int)__builtin_amdgcn_workitem_id_x(); asm volatile("" : "+v"(t)); return t; }
__device__ __forceinline__ bf16_t f2bf(float f) {
  unsigned u = __float_as_uint(f);
  u += 0x7fffu + ((u >> 16) & 1u);
  return (bf16_t)(u >> 16);
}
__device__ __forceinline__ unsigned pack2(float a, float b) { return (unsigned)f2bf(a) | ((unsigned)f2bf(b) << 16); }
__device__ __forceinline__ float bf2f(bf16_t b) { return __uint_as_float(((unsigned)b) << 16); }
__device__ __forceinline__ float sigmoid_(float x) { return 1.f / (1.f + __expf(-x)); }
__device__ __forceinline__ float silu_(float x) { return x * sigmoid_(x); }
__device__ __forceinline__ float gelu_tanh(float y) {
  float t = 0.7978845608028654f * (y + 0.044715f * y * y * y);
  float th = 1.f - 2.f / (__expf(2.f * t) + 1.f);
  return 0.5f * y * (1.f + th);
}
__device__ __forceinline__ float wave_sum(float v) {
#pragma unroll
  for (int o = 32; o > 0; o >>= 1) v += __shfl_xor(v, o);
  return v;
}
__device__ __forceinline__ int variant_of(int n) { return n < NCTX ? 0 : 1 + ((n - NCTX) >> 10); }
__device__ __forceinline__ float lbv(PRef P, int l, int c) {
  if (l == 0) return 0.f;
  float x0 = P.hg_lb[c], x1 = P.hg_lb[256 + c];
  return 1.f / (1.f + __expf(x0 - x1));
}

__device__ __forceinline__ size_t blk_off(int r, int k, int K) {
  return ((size_t)(r >> 7) * (size_t)(K >> 5) + (size_t)(k >> 5)) * 4096 + (size_t)((r & 127) * 32 + (k & 31));
}
template <int NI = 4, bool HOT = false, bool PERM = false, class Epi>
__device__ __forceinline__ void gemm_tile(const bf16_t* __restrict__ A, const bf16_t* __restrict__ B, int nk,
                                          char* lds, Epi epi) {
  const int tid = otid(), lane = tid & 63, w = tid >> 6, wr = w >> 1, wc = w & 1, fr = lane & 15, fq = lane >> 4;
  constexpr int NB = NI / 2;
  f32x4 acc[4][NI];
#pragma unroll
  for (int i = 0; i < 4; ++i)
#pragma unroll
    for (int j = 0; j < NI; ++j) acc[i][j] = (f32x4){0.f, 0.f, 0.f, 0.f};
  u32x4 ra[2], rb[NB];
  const int wsw = (0x1320 >> ((((tid >> 2) >> 2) & 3) * 4)) & 3;
  const int loff0 = (tid >> 2) * 64 + (((tid & 3) ^ wsw) << 4);
  const int rsw = (0x1320 >> (((fr >> 2) & 3) * 4)) & 3;
  const int aoff = (wr * 64 + fr) * 64 + ((fq ^ rsw) << 4);
  const int boff = 8192 + (wc * (16 * NI) + fr) * 64 + ((fq ^ rsw) << 4);
  const bf16_t* Ap = A + tid * 8;
  const bf16_t* Bp = B + tid * 8;
#define GT_LOAD()                                                                          \
  {                                                                                        \
    _Pragma("unroll") for (int i = 0; i < 2; ++i) ra[i] = *(const u32x4*)(Ap + 2048 * i);  \
    _Pragma("unroll") for (int i = 0; i < NB; ++i) rb[i] = *(const u32x4*)(Bp + 2048 * i); \
  }
#define GT_STORE(buf_)                                                                                         \
  {                                                                                                            \
    _Pragma("unroll") for (int i = 0; i < 2; ++i) *(u32x4*)(lds + (buf_) * 16384 + loff0 + 4096 * i) = ra[i];  \
    _Pragma("unroll") for (int i = 0; i < NB; ++i) *(u32x4*)(lds + (buf_) * 16384 + 8192 + loff0 + 4096 * i) = rb[i]; \
  }
  __syncthreads();
  GT_LOAD();
  GT_STORE(0);
  if (nk > 1) { if (!HOT) { Ap += 4096; Bp += 4096; } GT_LOAD(); }
  __syncthreads();
  for (int kt = 0; kt < nk; ++kt) {
    const int cur = kt & 1;
    if (kt + 1 < nk) GT_STORE(cur ^ 1);
    if (kt + 2 < nk) { if (!HOT) { Ap += 4096; Bp += 4096; } GT_LOAD(); }
    __builtin_amdgcn_sched_barrier(0);
    {
      const char* sb = lds + cur * 16384;
      bf16x8 af[4], bfr[NI];
#pragma unroll
      for (int mi = 0; mi < 4; ++mi) af[mi] = *(const bf16x8*)(sb + aoff + 1024 * mi);
#pragma unroll
      for (int ni = 0; ni < NI; ++ni) bfr[ni] = *(const bf16x8*)(sb + boff + 1024 * ni);
#pragma unroll
      for (int mi = 0; mi < 4; ++mi)
#pragma unroll
        for (int ni = 0; ni < NI; ++ni)
          acc[mi][ni] = __builtin_amdgcn_mfma_f32_16x16x32_bf16(bfr[ni], af[mi], acc[mi][ni], 0, 0, 0);
    }
    __syncthreads();
  }
  if constexpr (PERM) {
#pragma unroll
    for (int mi = 0; mi < 4; ++mi)
#pragma unroll
      for (int k = 0; k < NI / 2; ++k) epi(wr * 64 + mi * 16 + fr, wc * (16 * NI) + k * 32 + fq * 8, acc[mi][2 * k], acc[mi][2 * k + 1]);
  } else {
#pragma unroll
    for (int mi = 0; mi < 4; ++mi)
#pragma unroll
      for (int ni = 0; ni < NI; ++ni) epi(wr * 64 + mi * 16 + fr, wc * (16 * NI) + ni * 16 + fq * 4, acc[mi][ni]);
  }
}

__device__ void transpose_tile(const float* __restrict__ src, bf16_t* __restrict__ dst, int K, int N, int t, char* lds) {
  float* T = (float*)lds;
  const int tid = otid();
  const int ntn = N >> 6, kt = t / ntn, nt = t % ntn;
  __syncthreads();
#pragma unroll
  for (int i = 0; i < 4; ++i) {
    const int idx = tid + 256 * i, kr = idx >> 4, n4 = idx & 15;
    const float4 v = *(const float4*)(src + (size_t)(kt * 64 + kr) * N + nt * 64 + n4 * 4);
    T[kr * 65 + n4 * 4 + 0] = v.x; T[kr * 65 + n4 * 4 + 1] = v.y; T[kr * 65 + n4 * 4 + 2] = v.z; T[kr * 65 + n4 * 4 + 3] = v.w;
  }
  __syncthreads();
#pragma unroll
  for (int i = 0; i < 2; ++i) {
    const int idx = tid + 256 * i, n = idx >> 3, kc = idx & 7;
    uint4 o;
    o.x = pack2(T[(kc * 8 + 0) * 65 + n], T[(kc * 8 + 1) * 65 + n]);
    o.y = pack2(T[(kc * 8 + 2) * 65 + n], T[(kc * 8 + 3) * 65 + n]);
    o.z = pack2(T[(kc * 8 + 4) * 65 + n], T[(kc * 8 + 5) * 65 + n]);
    o.w = pack2(T[(kc * 8 + 6) * 65 + n], T[(kc * 8 + 7) * 65 + n]);
    const int cfull = nt * 64 + n, c32 = cfull & 31, rho = ((c32 >> 2) & 1) * 16 + (c32 >> 3) * 4 + (c32 & 3);
    *(uint4*)(dst + blk_off((cfull & ~31) + rho, kt * 64 + kc * 8, K)) = o;
  }
}

__device__ void ada_unit(PRef P, int u, char* lds) {
  float* sv = (float*)lds;
  const int tid = otid();
  const int l = u / 384, r = u % 384, jb = r / 16, ks = r % 16;
  __syncthreads();
  if (tid < 192) {
    const int v = tid >> 6, k = ks * 64 + (tid & 63);
    const float cv = (v == 0) ? P.c_ctx[k] : P.c[(v - 1) * 1024 + k];
    sv[tid] = silu_(cv);
  }
  __syncthreads();
  const int j = jb * 256 + tid;
  const float* wp = P.w_ada + ((size_t)l * 1024 + ks * 64) * 6144 + j;
  float a0 = 0.f, a1 = 0.f, a2 = 0.f;
#pragma unroll 8
  for (int k = 0; k < 64; ++k) {
    const float wv = wp[(size_t)k * 6144];
    a0 += sv[k] * wv; a1 += sv[64 + k] * wv; a2 += sv[128 + k] * wv;
  }
  if (ks == 0) { const float bj = P.b_ada[l * 6144 + j]; a0 += bj; a1 += bj; a2 += bj; }
  float* mp = P.mod + (size_t)(l * 3) * 6144 + j;
  __hip_atomic_fetch_add(mp, a0, __ATOMIC_RELAXED, __HIP_MEMORY_SCOPE_AGENT);
  __hip_atomic_fetch_add(mp + 6144, a1, __ATOMIC_RELAXED, __HIP_MEMORY_SCOPE_AGENT);
  __hip_atomic_fetch_add(mp + 2 * 6144, a2, __ATOMIC_RELAXED, __HIP_MEMORY_SCOPE_AGENT);
}

__device__ void s5pre_unit(PRef P, int u, char* lds) {
  float2* apw = (float2*)lds;
  float2* bb = apw + 64 * 33;
  float2* cc = bb + 64 * 16;
  const int tid = otid();
  const int ldg = u >> 2, part = u & 3;
  __syncthreads();
  {
    const int p = tid & 63, q = tid >> 6;
    const float are = P.s5_a_re[ldg * 64 + p], aim = P.s5_a_im[ldg * 64 + p];
    const float dt = expf(P.s5_log_dt[ldg]);
    for (int k = q; k < 10; k += 4) {
      const int tau = (k < 8) ? part * 8 + k : (k == 8 ? 1 : 32);
      const float mag = expf((float)tau * are * dt);
      const float ang = (float)tau * aim * dt;
      float sn, cs;
      sincosf(ang, &sn, &cs);
      const float2 v = make_float2(mag * cs, mag * sn);
      apw[p * 33 + tau] = v;
      if (k < 8 || (k == 9 && part == 3)) P.apow[((size_t)ldg * 64 + p) * 33 + tau] = v;
    }
  }
  __syncthreads();
  for (int e = tid; e < 1024; e += 256) {
    const int p = e >> 4, hh = e & 15;
    const float are = P.s5_a_re[ldg * 64 + p], aim = P.s5_a_im[ldg * 64 + p];
    const float2 ab = apw[p * 33 + 1];
    const float nr = ab.x - 1.f, ni = ab.y, den = are * are + aim * aim;
    const float cr = (nr * are + ni * aim) / den, ci = (ni * are - nr * aim) / den;
    const float br = P.s5_b_re[((size_t)ldg * 64 + p) * 16 + hh], bi = P.s5_b_im[((size_t)ldg * 64 + p) * 16 + hh];
    const float2 v = make_float2(cr * br - ci * bi, cr * bi + ci * br);
    bb[p * 16 + hh] = v;
    if (part == 0) P.bbar[((size_t)ldg * 64 + p) * 16 + hh] = v;
    const int h2 = e >> 6, p2 = e & 63;
    cc[h2 * 64 + p2] = make_float2(P.s5_c_re[((size_t)ldg * 16 + h2) * 64 + p2], P.s5_c_im[((size_t)ldg * 16 + h2) * 64 + p2]);
  }
  __syncthreads();
  for (int e = tid; e < 2048; e += 256) {
    const int tau = part * 8 + (e >> 8), hh = (e >> 4) & 15, h2 = e & 15;
    float s = 0.f;
    for (int p = 0; p < 64; ++p) {
      const float2 c = cc[hh * 64 + p], a = apw[p * 33 + tau], b = bb[p * 16 + h2];
      const float tr = a.x * b.x - a.y * b.y, ti = a.x * b.y + a.y * b.x;
      s += c.x * tr - c.y * ti;
    }
    P.ktab[(size_t)ldg * 8192 + tau * 256 + (e & 255)] = s;
  }
}

struct TrDesc { const float* src; bf16_t* dst; int K, N, tile; };
__device__ __forceinline__ TrDesc tr_decode(PRef P, int u) {
  TrDesc D;
  if (u < 2048) { const int l = u >> 10; D.src = P.w_mlp1 + (size_t)l * 1024 * 4096; D.dst = P.wt_m1 + (size_t)l * 4096 * 1024; D.K = 1024; D.N = 4096; D.tile = u & 1023; return D; }
  u -= 2048;
  if (u < 2048) { const int l = u >> 10; D.src = P.w_mlp2 + (size_t)l * 4096 * 1024; D.dst = P.wt_m2 + (size_t)l * 1024 * 4096; D.K = 4096; D.N = 1024; D.tile = u & 1023; return D; }
  u -= 2048;
  if (u < 1536) { const int l = u / 768; D.src = P.w_in + (size_t)l * 1024 * 3072; D.dst = P.wt_in + (size_t)l * 3072 * 1024; D.K = 1024; D.N = 3072; D.tile = u % 768; return D; }
  u -= 1536;
  if (u < 512) { const int l = u >> 8; D.src = P.w_out + (size_t)l * 1024 * 1024; D.dst = P.wt_out + (size_t)l * 1024 * 1024; D.K = 1024; D.N = 1024; D.tile = u & 255; return D; }
  u -= 512;
  { const int l = u >> 4; D.src = P.s5_w_glu + (size_t)l * 256 * 256; D.dst = P.wt_glu + (size_t)l * 256 * 256; D.K = 256; D.N = 256; D.tile = u & 15; return D; }
}
#define TR_NTILES 6176
#define TR_LOAD(r_, D_)                                                                                        \
  {                                                                                                            \
    const int ntn_ = (D_).N >> 6, kt_ = (D_).tile / ntn_, nt_ = (D_).tile % ntn_;                              \
    _Pragma("unroll") for (int i = 0; i < 4; ++i) {                                                            \
      const int idx = tid + 256 * i, kr = idx >> 4, n4 = idx & 15;                                             \
      r_[i] = *(const f32x4*)((D_).src + (size_t)(kt_ * 64 + kr) * (D_).N + nt_ * 64 + n4 * 4);               \
    }                                                                                                          \
  }

__device__ void phase0a(PRef P, char* lds) {
  const int tid = otid();
  const int G = gridDim.x;
  for (int u0 = blockIdx.x; u0 < 256 + 768 + 128; u0 += G) {
    int u = u0;
    if (u < 256) { s5pre_unit(P, u, lds); continue; }
    u -= 256;
    if (u < 768) { ada_unit(P, u, lds); continue; }
    u -= 768;
    {
      const int c = u, which = c >> 6;
      const float* src = (which ? P.cache_v : P.cache_k) + (size_t)(c & 63) * 16384;
      bf16_t* dst = (which ? P.cvb : P.ckb) + (size_t)(c & 63) * 16384;
#pragma unroll
      for (int i = 0; i < 8; ++i) {
        const int e = (tid + 256 * i) * 8;
        const f32x4 a = *(const f32x4*)(src + e), b = *(const f32x4*)(src + e + 4);
        u32x4 o; o.x = pack2(a[0], a[1]); o.y = pack2(a[2], a[3]); o.z = pack2(b[0], b[1]); o.w = pack2(b[2], b[3]);
        *(u32x4*)(dst + e) = o;
      }
    }
  }
  float* T = (float*)lds;
  int t = blockIdx.x;
  f32x4 r[4], rn[4];
  TrDesc D = tr_decode(P, t < TR_NTILES ? t : 0), Dn = D;
  if (t < TR_NTILES) TR_LOAD(r, D);
  while (t < TR_NTILES) {
    const int tn = t + G;
    if (tn < TR_NTILES) { Dn = tr_decode(P, tn); TR_LOAD(rn, Dn); }
    __syncthreads();
#pragma unroll
    for (int i = 0; i < 4; ++i) {
      const int idx = tid + 256 * i, kr = idx >> 4, n4 = idx & 15;
      T[kr * 65 + n4 * 4 + 0] = r[i][0]; T[kr * 65 + n4 * 4 + 1] = r[i][1]; T[kr * 65 + n4 * 4 + 2] = r[i][2]; T[kr * 65 + n4 * 4 + 3] = r[i][3];
    }
    __syncthreads();
    {
      const int ntn = D.N >> 6, kt = D.tile / ntn, nt = D.tile % ntn;
#pragma unroll
      for (int i = 0; i < 2; ++i) {
        const int idx = tid + 256 * i, n = idx >> 3, kc = idx & 7;
        u32x4 o;
        o.x = pack2(T[(kc * 8 + 0) * 65 + n], T[(kc * 8 + 1) * 65 + n]);
        o.y = pack2(T[(kc * 8 + 2) * 65 + n], T[(kc * 8 + 3) * 65 + n]);
        o.z = pack2(T[(kc * 8 + 4) * 65 + n], T[(kc * 8 + 5) * 65 + n]);
        o.w = pack2(T[(kc * 8 + 6) * 65 + n], T[(kc * 8 + 7) * 65 + n]);
        const int cfull = nt * 64 + n, c32 = cfull & 31, rho = ((c32 >> 2) & 1) * 16 + (c32 >> 3) * 4 + (c32 & 3);
        *(u32x4*)(D.dst + blk_off((cfull & ~31) + rho, kt * 64 + kc * 8, D.K)) = o;
      }
    }
#pragma unroll
    for (int i = 0; i < 4; ++i) r[i] = rn[i];
    D = Dn;
    t = tn;
  }
}

__device__ void phase0b(PRef P) {
  const size_t gtid = (size_t)blockIdx.x * 256 + otid(), gsz = (size_t)gridDim.x * 256;
}

__device__ void tables_expand(PRef P) {
  const size_t gtid = (size_t)blockIdx.x * 256 + otid(), gsz = (size_t)gridDim.x * 256;
  for (size_t e8 = gtid; e8 < (size_t)2 * 16 * 512 * 96; e8 += gsz) {
    const int k0 = (int)(e8 % 96) * 8;
    const int m = (int)((e8 / 96) % 512);
    const int lg = (int)(e8 / (96 * 512));
    const int l = lg >> 4, g = lg & 15, i = m >> 4, hh = m & 15;
    const int ldg0 = (l * 2 + 0) * 16 + g, ldg1 = (l * 2 + 1) * 16 + g;
    float v[8];
    if (k0 < 512) {
      const int j = k0 >> 4, h2 = k0 & 15;
      f32x4 a0 = (f32x4){0.f, 0.f, 0.f, 0.f}, a1 = a0, b0 = a0, b1 = a0;
      if (j <= i) { const float* kp = P.ktab + (size_t)ldg0 * 8192 + (i - j) * 256 + hh * 16 + h2; a0 = *(const f32x4*)kp; a1 = *(const f32x4*)(kp + 4); }
      if (j >= i) { const float* kp = P.ktab + (size_t)ldg1 * 8192 + (j - i) * 256 + hh * 16 + h2; b0 = *(const f32x4*)kp; b1 = *(const f32x4*)(kp + 4); }
      const float dsk = P.s5_d[l * 256 + g * 16 + hh];
#pragma unroll
      for (int q = 0; q < 4; ++q) { v[q] = a0[q] + b0[q]; v[4 + q] = a1[q] + b1[q]; }
      if (j == i && hh >= h2 && hh < h2 + 8) {
#pragma unroll
        for (int q = 0; q < 8; ++q) if (q == hh - h2) v[q] += dsk;
      }
    } else {
      const int d = (k0 >= 640) ? 1 : 0;
      const int p0 = ((k0 - 512) & 127) >> 1;
      const int ldg = d ? ldg1 : ldg0;
      const int pw = d ? (32 - i) : (i + 1);
      const f32x4 cr = *(const f32x4*)(P.s5_c_re + ((size_t)ldg * 16 + hh) * 64 + p0), ci = *(const f32x4*)(P.s5_c_im + ((size_t)ldg * 16 + hh) * 64 + p0);
      float2 a[4];
#pragma unroll
      for (int q = 0; q < 4; ++q) a[q] = P.apow[((size_t)ldg * 64 + p0 + q) * 33 + pw];
#pragma unroll
      for (int q = 0; q < 4; ++q) { v[2 * q] = cr[q] * a[q].x - ci[q] * a[q].y; v[2 * q + 1] = -(cr[q] * a[q].y + ci[q] * a[q].x); }
    }
    u32x4 o; o.x = pack2(v[0], v[1]); o.y = pack2(v[2], v[3]); o.z = pack2(v[4], v[5]); o.w = pack2(v[6], v[7]);
    *(u32x4*)(P.atab + (size_t)lg * 512 * 768 + blk_off(m, k0, 768)) = o;
  }
  for (size_t e8 = gtid; e8 < (size_t)2 * 16 * 256 * 64; e8 += gsz) {
    const int k0 = (int)(e8 % 64) * 8;
    const int row = (int)((e8 / 64) % 256);
    const int lg = (int)(e8 / (64 * 256));
    const int l = lg >> 4, g = lg & 15;
    const int d = row >> 7, p = (row & 127) >> 1, ri = row & 1;
    const int ldg = (l * 2 + d) * 16 + g;
    const int j = k0 >> 4, h2 = k0 & 15;
    const int pw = d ? j : (31 - j);
    const float2 a = P.apow[((size_t)ldg * 64 + p) * 33 + pw];
    const f32x4* bp = (const f32x4*)(P.bbar + ((size_t)ldg * 64 + p) * 16 + h2);
    const f32x4 b0 = bp[0], b1 = bp[1], b2 = bp[2], b3 = bp[3];
    const float br[8] = {b0[0], b0[2], b1[0], b1[2], b2[0], b2[2], b3[0], b3[2]};
    const float bi[8] = {b0[1], b0[3], b1[1], b1[3], b2[1], b2[3], b3[1], b3[3]};
    float v[8];
#pragma unroll
    for (int q = 0; q < 8; ++q) v[q] = ri ? (a.x * bi[q] + a.y * br[q]) : (a.x * br[q] - a.y * bi[q]);
    u32x4 o; o.x = pack2(v[0], v[1]); o.y = pack2(v[2], v[3]); o.z = pack2(v[4], v[5]); o.w = pack2(v[6], v[7]);
    *(u32x4*)(P.wtab + (size_t)lg * 256 * 512 + blk_off(row, k0, 512)) = o;
  }
}

__device__ void normmod_phase(PRef P, int l, int which) {
  const int lane = otid() & 63, w = otid() >> 6;
  const float* gam = (which == 0 ? P.norm_mix : P.norm_mlp) + l * 1024;
  const bool addp = (which == 0 && l > 0);
  for (int n = blockIdx.x * 4 + w; n < NTOK; n += gridDim.x * 4) {
    float* xr = P.out + (size_t)n * 1024;
    const float* xin = (l == 0 && which == 0) ? (n < NCTX ? P.x_prompt + (size_t)n * 1024 : P.x_sample + (size_t)(n - NCTX) * 1024) : xr;
    const float* md = P.mod + ((size_t)(l * 3 + variant_of(n))) * 6144 + (which == 0 ? 0 : 3072);
    f32x4 v[4];
    float ss = 0.f;
#pragma unroll
    for (int i = 0; i < 4; ++i) {
      const int k = lane * 8 + 512 * (i >> 1) + 4 * (i & 1);
      v[i] = *(const f32x4*)(xin + k);
      if (addp) {
        v[i] = v[i] + *(const f32x4*)(P.pbuf + (size_t)n * 1024 + k);
        *(f32x4*)(xr + k) = v[i];
      }
      ss += v[i][0] * v[i][0] + v[i][1] * v[i][1] + v[i][2] * v[i][2] + v[i][3] * v[i][3];
    }
    f32x4 gq[4], shq[4], scq[4];
#pragma unroll
    for (int i = 0; i < 4; ++i) {
      const int k = lane * 8 + 512 * (i >> 1) + 4 * (i & 1);
      gq[i] = *(const f32x4*)(gam + k); shq[i] = *(const f32x4*)(md + k); scq[i] = *(const f32x4*)(md + 1024 + k);
    }
    ss = wave_sum(ss);
    const float rstd = rsqrtf(ss * (1.f / 1024.f) + 1e-6f);
#pragma unroll
    for (int j = 0; j < 2; ++j) {
      const int k = lane * 8 + 512 * j;
      const f32x4 o0 = v[2 * j] * rstd * gq[2 * j] * (1.f + scq[2 * j]) + shq[2 * j];
      const f32x4 o1 = v[2 * j + 1] * rstd * gq[2 * j + 1] * (1.f + scq[2 * j + 1]) + shq[2 * j + 1];
      u32x4 ov; ov.x = pack2(o0[0], o0[1]); ov.y = pack2(o0[2], o0[3]); ov.z = pack2(o1[0], o1[1]); ov.w = pack2(o1[2], o1[3]);
      *(u32x4*)(P.h + blk_off(n, k, 1024)) = ov;
    }
  }
  if (l == 0 && which == 0) tables_expand(P);
}

__device__ void final_phase(PRef P) {
  const int lane = otid() & 63, w = otid() >> 6;
  for (int n = blockIdx.x * 4 + w; n < NTOK; n += gridDim.x * 4) {
    float* xr = P.out + (size_t)n * 1024;
    f32x4 v[4];
    float ss = 0.f;
#pragma unroll
    for (int i = 0; i < 4; ++i) {
      v[i] = *(const f32x4*)(xr + lane * 4 + 256 * i) + *(const f32x4*)(P.pbuf + (size_t)n * 1024 + lane * 4 + 256 * i);
      ss += v[i][0] * v[i][0] + v[i][1] * v[i][1] + v[i][2] * v[i][2] + v[i][3] * v[i][3];
    }
    ss = wave_sum(ss);
    const float rstd = rsqrtf(ss * (1.f / 1024.f) + 1e-6f);
#pragma unroll
    for (int i = 0; i < 4; ++i) {
      const int k = lane * 4 + 256 * i;
      const f32x4 g = *(const f32x4*)(P.norm_final + k);
      *(f32x4*)(xr + k) = v[i] * rstd * g;
    }
  }
}

__device__ void win_phase(PRef P, int l, char* lds) {
  for (int u = blockIdx.x; u < 48 * 24; u += gridDim.x) {
    const int mt = u / 24, nt = u % 24, m0 = mt * 128, n0 = nt * 128;
    gemm_tile<4, false, true>(P.h + blk_off(m0, 0, 1024), P.wt_in + (size_t)l * 3072 * 1024 + blk_off(n0, 0, 1024), 32, lds,
      [&](int rl, int cl, f32x4 v, f32x4 w2) {
        const int n = m0 + rl, c = n0 + cl;
        u32x4 zo; zo.x = pack2(v[0], v[1]); zo.y = pack2(v[2], v[3]); zo.z = pack2(w2[0], w2[1]); zo.w = pack2(w2[2], w2[3]);
        *(u32x4*)(P.z + (size_t)n * 3072 + c) = zo;
        if (c < 256) {
          if (n < NCTX && ((n & 255) == 0 || (n & 255) == 255)) {
            float* ue = P.uedge + (size_t)((n >> 8) * 2 + ((n & 255) ? 1 : 0)) * 256 + c;
            *(f32x4*)ue = v; *(f32x4*)(ue + 4) = w2;
          }
          const int g = c >> 4;
          *(u32x4*)(P.bts5 + (size_t)g * 256 * 768 + blk_off(n >> 5, (n & 31) * 16 + (c & 15), 768)) = zo;
        }
        if (c >= 2048 && n < NCTX) {
          const int b = n >> 8, t = n & 255;
          float* dst = P.out + (c < 2560 ? OUT_CK : OUT_CV) + ((size_t)((b * 2 + l) * 256 + t)) * 512 + ((c - 2048) & 511);
          *(f32x4*)dst = v; *(f32x4*)(dst + 4) = w2;
        }
      });
  }
}

template <bool DUMMY = false>
__device__ void wout_phase(PRef P, int l, char* lds) {
  for (int u = blockIdx.x; u < 48 * 16; u += gridDim.x) {
    const int mt = u / 16, nt = u % 16, m0 = mt * 128, n0 = nt * 64;
    gemm_tile<2, false, true>(P.mix + blk_off(m0, 0, 1024), P.wt_out + (size_t)l * 1024 * 1024 + blk_off(n0, 0, 1024), 32, lds,
      [&](int rl, int cl, f32x4 v, f32x4 w2) {
        const int n = m0 + rl, c = n0 + cl;
        const float* gp = P.mod + ((size_t)(l * 3 + variant_of(n))) * 6144 + 2048 + c;
        f32x4* xp = (f32x4*)((DUMMY ? P.kv : P.out) + (size_t)n * 1024 + c);
        const f32x4* xs = (l == 0) ? (const f32x4*)((n < NCTX ? P.x_prompt + (size_t)n * 1024 : P.x_sample + (size_t)(n - NCTX) * 1024) + c) : xp;
        const f32x4 x0 = xs[0], x1 = xs[1];
        xp[0] = x0 + *(const f32x4*)gp * v; xp[1] = x1 + *(const f32x4*)(gp + 4) * w2;
      });
  }
}

__device__ void mlp1_phase(PRef P, int l, char* lds) {
  for (int u = blockIdx.x; u < 48 * 32; u += gridDim.x) {
    const int mt = u / 32, nt = u % 32, m0 = mt * 128, n0 = nt * 128;
    gemm_tile<4, false, true>(P.h + blk_off(m0, 0, 1024), P.wt_m1 + (size_t)l * 4096 * 1024 + blk_off(n0, 0, 1024), 32, lds,
      [&](int rl, int cl, f32x4 v, f32x4 w2) {
        const int n = m0 + rl, c = n0 + cl;
        const f32x4 z4 = (f32x4){0.f, 0.f, 0.f, 0.f};
        const f32x4 a = __builtin_elementwise_max(v, z4), b = __builtin_elementwise_max(w2, z4);
        const f32x4 aa = a * a, bb = b * b;
        u32x4 o; o.x = pack2(aa[0], aa[1]); o.y = pack2(aa[2], aa[3]); o.z = pack2(bb[0], bb[1]); o.w = pack2(bb[2], bb[3]);
        *(u32x4*)(P.hid + blk_off(n, c, 4096)) = o;
      });
  }
}

template <bool HOT>
__device__ void mlp1_dummy_phase(PRef P, int l, char* lds) {
  for (int u = blockIdx.x; u < 48 * 32; u += gridDim.x) {
    const int mt = u / 32, nt = u % 32, m0 = mt * 128, n0 = nt * 128;
    gemm_tile<4, HOT>(P.h + blk_off(m0, 0, 1024), P.wt_m1 + (size_t)l * 4096 * 1024 + blk_off(n0, 0, 1024), 32, lds,
      [&](int rl, int cl, f32x4 v) {
        if (v[0] == 12345.678f) P.kv[rl * 128 + cl] = v[1];
      });
  }
}

template <bool DUMMY = false>
__device__ void mlp2_phase(PRef P, int l, char* lds) {
  for (int u = blockIdx.x; u < 48 * 8 * 2; u += gridDim.x) {
    const int ks = u & 1, t = u >> 1, mt = t / 8, nt = t % 8, m0 = mt * 128, n0 = nt * 128;
    gemm_tile<4, false, true>(P.hid + blk_off(m0, ks * 2048, 4096), P.wt_m2 + (size_t)l * 1024 * 4096 + blk_off(n0, ks * 2048, 4096), 64, lds,
      [&](int rl, int cl, f32x4 v, f32x4 w2) {
        const int n = m0 + rl, c = n0 + cl;
        const float* gp = P.mod + ((size_t)(l * 3 + variant_of(n))) * 6144 + 5120 + c;
        const f32x4 g0 = *(const f32x4*)gp, g1 = *(const f32x4*)(gp + 4);
        if (ks == 0) {
          f32x4* xp = (f32x4*)((DUMMY ? P.kv : P.out) + (size_t)n * 1024 + c);
          const f32x4 x0 = xp[0], x1 = xp[1];
          xp[0] = x0 + g0 * v; xp[1] = x1 + g1 * w2;
        } else {
          f32x4* pp = (f32x4*)((DUMMY ? P.kv : P.pbuf) + (size_t)n * 1024 + c);
          pp[0] = g0 * v; pp[1] = g1 * w2;
        }
      });
  }
}

__device__ void s5e_unit(PRef P, int l, int u, char* lds) {
  const int g = u >> 2, mt = (u >> 1) & 1, nt = u & 1;
  gemm_tile(P.bts5 + (size_t)g * 256 * 768 + blk_off(nt * 128, 0, 768), P.wtab + (size_t)(l * 16 + g) * 256 * 512 + blk_off(mt * 128, 0, 512), 16, lds,
    [&](int rl, int cl, f32x4 v) {
      const int col = nt * 128 + rl, m = mt * 128 + cl;
      if (col < 192) *(f32x4*)(P.E + ((size_t)(g * 192 + col)) * 256 + m) = v;
    });
}

__device__ void s5y_unit(PRef P, int l, int u, char* lds) {
  const int g = u >> 4, mt = (u >> 1) & 7, nt = u & 1;
  gemm_tile<2>(P.bts5 + (size_t)g * 256 * 768 + blk_off(nt * 128, 0, 768), P.atab + (size_t)(l * 16 + g) * 512 * 768 + blk_off(mt * 64, 0, 768), 24, lds,
    [&](int rl, int cl, f32x4 v) {
      const int col = nt * 128 + rl, m = mt * 64 + cl;
      if (col < 192) {
        const int i = m >> 4, hh = m & 15, n = col * 32 + i;
        uint2 o; o.x = pack2(gelu_tanh(v[0]), gelu_tanh(v[1])); o.y = pack2(gelu_tanh(v[2]), gelu_tanh(v[3]));
        *(uint2*)(P.xg + blk_off(n, g * 16 + hh, 256)) = o;
      }
    });
}

__device__ void glu_unit(PRef P, int l, int u, char* lds) {
  {
    const int mt = u >> 1, nt = u & 1, m0 = mt * 128, n0 = nt * 128;
    gemm_tile<4, false, true>(P.xg + blk_off(m0, 0, 256), P.wt_glu + (size_t)l * 256 * 256 + blk_off(n0, 0, 256), 8, lds,
      [&](int rl, int cl, f32x4 v, f32x4 w2) {
        const int n = m0 + rl, c = n0 + cl;
        const u32x4 xv = *(const u32x4*)(P.xg + blk_off(n, c, 256));
        const float* bp = P.s5_b_glu + l * 256 + c;
        const f32x4 b0 = *(const f32x4*)bp, b1 = *(const f32x4*)(bp + 4);
        u32x4 o;
        o.x = pack2(bf2f((bf16_t)(xv.x & 0xffff)) * sigmoid_(v[0] + b0[0]), bf2f((bf16_t)(xv.x >> 16)) * sigmoid_(v[1] + b0[1]));
        o.y = pack2(bf2f((bf16_t)(xv.y & 0xffff)) * sigmoid_(v[2] + b0[2]), bf2f((bf16_t)(xv.y >> 16)) * sigmoid_(v[3] + b0[3]));
        o.z = pack2(bf2f((bf16_t)(xv.z & 0xffff)) * sigmoid_(w2[0] + b1[0]), bf2f((bf16_t)(xv.z >> 16)) * sigmoid_(w2[1] + b1[1]));
        o.w = pack2(bf2f((bf16_t)(xv.w & 0xffff)) * sigmoid_(w2[2] + b1[2]), bf2f((bf16_t)(xv.w >> 16)) * sigmoid_(w2[3] + b1[3]));
        *(u32x4*)(P.mix + blk_off(n, c, 1024)) = o;
      });
  }
}

__device__ void attn_unit(PRef P, int l, int unit, char* lds) {
  char* Ks = lds;
  bf16_t* Vt = (bf16_t*)(lds + 8192);
  float* rpbS = (float*)(lds + 8192 + 64 * 68 * 2);
  const int tid = otid(), lane = tid & 63, w = tid >> 6, fr = lane & 15, fq = lane >> 4;
  const bool lat = unit < 256;
  int b, h, qrow0, ntiles, r = 0, r_start = 0;
  if (lat) { b = unit >> 7; h = (unit >> 4) & 7; r = unit & 15; qrow0 = NCTX + b * 1024 + r * 64; ntiles = 16; r_start = min(max(r - 4, 0), 8); }
  else { const int v = unit - 256; b = v >> 5; h = (v >> 2) & 7; qrow0 = b * 256 + (v & 3) * 64; ntiles = 4; }
  __syncthreads();
  if (lat) for (int i = tid; i < 465; i += 256) rpbS[i] = P.na_rpb[(size_t)((l * 8 + h) * 15) * 31 + i];
  bf16x8 qf[2];
  {
    const bf16_t* zq = P.z + (size_t)(qrow0 + w * 16 + fr) * 3072 + 1536 + h * 64;
#pragma unroll
    for (int ks = 0; ks < 2; ++ks) {
      const bf16x8 a = *(const bf16x8*)(zq + ks * 32 + fq * 8);
#pragma unroll
      for (int j = 0; j < 8; ++j) qf[ks][j] = (short)f2bf(bf2f((bf16_t)a[j]) * 0.125f);
    }
  }
  const int bandw = __builtin_amdgcn_readfirstlane(min(max(w * 16 - 8, 0), 32));
  float m = -INFINITY, lsum = 0.f;
  f32x4 o[4];
#pragma unroll
  for (int i = 0; i < 4; ++i) o[i] = (f32x4){0.f, 0.f, 0.f, 0.f};
  u32x4 kr[2], vr[2];
#define ATT_LOAD_TILE(t_)                                                                                              \
  {                                                                                                                    \
    const int tt = (t_);                                                                                               \
    const bf16_t* kp; const bf16_t* vp; int ld;                                                                        \
    if (lat && tt < 8) {                            \
      const size_t base = ((size_t)((b * 2 + l) * 512 + tt * 64)) * 512 + h * 64;                                      \
      kp = P.ckb + base; vp = P.cvb + base; ld = 512;                                                                  \
    } else {                                                            \
      const int row0 = lat ? (NCTX + b * 1024 + (r_start + tt - 8) * 64) : (b * 256 + tt * 64);                        \
      kp = P.z + (size_t)row0 * 3072 + 2048 + h * 64; vp = kp + 512; ld = 3072;                                        \
    }                                                                                                                  \
    _Pragma("unroll") for (int i = 0; i < 2; ++i) {                                                                    \
      const int c = tid + 256 * i, key = c >> 3, ch = c & 7;                                                           \
      kr[i] = *(const u32x4*)(kp + (size_t)key * ld + ch * 8);                                                         \
      vr[i] = *(const u32x4*)(vp + (size_t)key * ld + ch * 8);                                                         \
    }                                                                                                                  \
  }
  ATT_LOAD_TILE(0);
  for (int t = 0; t < ntiles; ++t) {
    __syncthreads();
#pragma unroll
    for (int i = 0; i < 2; ++i) {
      const int c = tid + 256 * i, key = c >> 3, ch = c & 7;
      *(u32x4*)(Ks + key * 128 + ((ch ^ ((key >> 1) & 7)) << 4)) = kr[i];
      const u32x4 vb = vr[i];
#pragma unroll
      for (int e = 0; e < 4; ++e) {
        Vt[(ch * 8 + 2 * e) * 68 + key] = (bf16_t)(vb[e] & 0xffffu);
        Vt[(ch * 8 + 2 * e + 1) * 68 + key] = (bf16_t)(vb[e] >> 16);
      }
    }
    __syncthreads();
    if (t + 1 < ntiles) ATT_LOAD_TILE(t + 1);
    __builtin_amdgcn_sched_barrier(0);
    const bool win = lat && t >= 8;
    const int band = win ? bandw : 0;
    const int nkt = win ? 2 : 4;
    f32x4 s[4];
#pragma unroll
    for (int kt = 0; kt < 4; ++kt) {
      if (kt < nkt) {
        s[kt] = (f32x4){0.f, 0.f, 0.f, 0.f};
        const int key = band + kt * 16 + fr;
#pragma unroll
        for (int ks = 0; ks < 2; ++ks) {
          const bf16x8 a = *(const bf16x8*)(Ks + key * 128 + (((ks * 4 + fq) ^ ((key >> 1) & 7)) << 4));
          s[kt] = __builtin_amdgcn_mfma_f32_16x16x32_bf16(a, qf[ks], s[kt], 0, 0, 0);
        }
      } else {
        s[kt] = (f32x4){-1e30f, -1e30f, -1e30f, -1e30f};
      }
    }
    if (win) {
      const int dr = r_start + (t - 8) - r + 7;
      const int qc = w * 16 + fr;
      const int cs = min(max(qc - 8, 0), 48);
#pragma unroll
      for (int kt = 0; kt < 2; ++kt)
#pragma unroll
        for (int rr = 0; rr < 4; ++rr) {
          const int kc = band + kt * 16 + fq * 4 + rr;
          const bool in = (kc >= cs) && (kc < cs + 16);
          const int dc = min(max(kc - qc + 15, 0), 30);
          s[kt][rr] = in ? s[kt][rr] + rpbS[dr * 31 + dc] : -1e30f;
        }
    }
    float mx = -INFINITY;
#pragma unroll
    for (int kt = 0; kt < 4; ++kt)
#pragma unroll
      for (int rr = 0; rr < 4; ++rr) mx = fmaxf(mx, s[kt][rr]);
    mx = fmaxf(mx, __shfl_xor(mx, 16));
    mx = fmaxf(mx, __shfl_xor(mx, 32));
    const float mn = fmaxf(m, mx);
    const float alpha = __expf(m - mn);
    float ps = 0.f;
#pragma unroll
    for (int kt = 0; kt < 4; ++kt)
#pragma unroll
      for (int rr = 0; rr < 4; ++rr) { s[kt][rr] = __expf(s[kt][rr] - mn); ps += s[kt][rr]; }
    ps += __shfl_xor(ps, 16);
    ps += __shfl_xor(ps, 32);
    lsum = lsum * alpha + ps;
    m = mn;
#pragma unroll
    for (int i = 0; i < 4; ++i) o[i] = o[i] * alpha;
#pragma unroll
    for (int c = 0; c < 2; ++c) {
      if (2 * c >= nkt) continue;
      bf16x8 pb;
      pb[0] = (short)f2bf(s[2 * c][0]); pb[1] = (short)f2bf(s[2 * c][1]); pb[2] = (short)f2bf(s[2 * c][2]); pb[3] = (short)f2bf(s[2 * c][3]);
      pb[4] = (short)f2bf(s[2 * c + 1][0]); pb[5] = (short)f2bf(s[2 * c + 1][1]); pb[6] = (short)f2bf(s[2 * c + 1][2]); pb[7] = (short)f2bf(s[2 * c + 1][3]);
#pragma unroll
      for (int dt = 0; dt < 4; ++dt) {
        const int d = dt * 16 + fr;
        const u32x2 lo = *(const u32x2*)(Vt + d * 68 + band + (2 * c) * 16 + fq * 4);
        const u32x2 hi = *(const u32x2*)(Vt + d * 68 + band + (2 * c + 1) * 16 + fq * 4);
        const u32x4 avu = (u32x4){lo.x, lo.y, hi.x, hi.y};
        o[dt] = __builtin_amdgcn_mfma_f32_16x16x32_bf16(__builtin_bit_cast(bf16x8, avu), pb, o[dt], 0, 0, 0);
      }
    }
  }
  const float inv = 1.f / lsum;
#pragma unroll
  for (int dt = 0; dt < 4; ++dt) {
    uint2 ov; ov.x = pack2(o[dt][0] * inv, o[dt][1] * inv); ov.y = pack2(o[dt][2] * inv, o[dt][3] * inv);
    *(uint2*)(P.mix + blk_off(qrow0 + w * 16 + fr, 512 + h * 64 + dt * 16 + fq * 4, 1024)) = ov;
  }
}

__device__ void hgrn_a_unit(PRef P, int l, int unit, char* lds) {
  float* fS = (float*)lds;
  float* vS = fS + 4096;
  const int tid = otid(), dv = tid & 63, q4 = tid >> 6;
  const int mc = unit >> 3, h = (unit >> 1) & 3, d = unit & 1, n0 = mc * 64;
  const int zfcol = (d == 0 ? 512 : 768) + h * 64;
  __syncthreads();
#pragma unroll 4
  for (int e = 0; e < 16; ++e) {
    const int idx = tid + 256 * e, s = idx >> 6, ch = idx & 63;
    const bf16_t* zrow = P.z + (size_t)(n0 + s) * 3072;
    const float lb = lbv(P, l, h * 64 + ch);
    fS[idx] = lb + (1.f - lb) * sigmoid_(bf2f(zrow[zfcol + ch]));
    vS[idx] = bf2f(zrow[1024 + h * 64 + ch]);
  }
  __syncthreads();
  f32x2 S[8];
#pragma unroll
  for (int j = 0; j < 8; ++j) S[j] = (f32x2){0.f, 0.f};
  for (int i = 0; i < 64; ++i) {
    const int s = d ? 63 - i : i;
    const float vv = vS[s * 64 + dv];
    const f32x2 vv2 = (f32x2){vv, vv};
#pragma unroll
    for (int j = 0; j < 8; ++j) {
      const f32x2 fv = *(const f32x2*)(fS + s * 64 + q4 * 16 + 2 * j);
      S[j] = fv * (S[j] - vv2) + vv2;
    }
  }
#pragma unroll
  for (int j = 0; j < 8; ++j) {
    P.kv[((size_t)unit * 64 + q4 * 16 + 2 * j) * 64 + dv] = S[j][0];
    P.kv[((size_t)unit * 64 + q4 * 16 + 2 * j + 1) * 64 + dv] = S[j][1];
  }
  if (tid < 64) {
    float g = 1.f;
    for (int s = 0; s < 64; ++s) g *= fS[s * 64 + tid];
    P.gdec[unit * 64 + tid] = g;
  }
}

__device__ void hgrn_b_unit(PRef P, int l, int unit, char* lds) {
  float* fS = (float*)lds;
  float* qS = fS + 1024;
  float* vS = qS + 1024;
  float* opart = vS + 1024;
  const int tid = otid(), dv = tid & 63, q4 = tid >> 6;
  const int mc = unit >> 3, h = (unit >> 1) & 3, d = unit & 1, n0 = mc * 64;
  f32x2 S[8];
#pragma unroll
  for (int j = 0; j < 8; ++j) {
    S[j][0] = P.sst[((size_t)unit * 64 + q4 * 16 + 2 * j) * 64 + dv];
    S[j][1] = P.sst[((size_t)unit * 64 + q4 * 16 + 2 * j + 1) * 64 + dv];
  }
  const int zfcol = (d == 0 ? 512 : 768) + h * 64;
  float rf[4], rq[4], rv[4], rlb[4];
#pragma unroll
  for (int e = 0; e < 4; ++e) rlb[e] = lbv(P, l, h * 64 + ((tid + 256 * e) & 63));
#define HG_LOAD(sub_)                                                                              \
  _Pragma("unroll") for (int e = 0; e < 4; ++e) {                                                  \
    const int idx = tid + 256 * e, i = idx >> 6, ch = idx & 63, tl = (sub_) * 16 + i, s = d ? 63 - tl : tl; \
    const bf16_t* zrow = P.z + (size_t)(n0 + s) * 3072;                                           \
    rf[e] = bf2f(zrow[zfcol + ch]); rq[e] = bf2f(zrow[256 + h * 64 + ch]); rv[e] = bf2f(zrow[1024 + h * 64 + ch]);  \
  }
  HG_LOAD(0);
  for (int sub = 0; sub < 4; ++sub) {
    __syncthreads();
#pragma unroll
    for (int e = 0; e < 4; ++e) {
      const int idx = tid + 256 * e;
      fS[idx] = rlb[e] + (1.f - rlb[e]) * sigmoid_(rf[e]);
      qS[idx] = silu_(rq[e]);
      vS[idx] = rv[e];
    }
    __syncthreads();
    if (sub + 1 < 4) HG_LOAD(sub + 1);
    __builtin_amdgcn_sched_barrier(0);
    for (int i = 0; i < 16; ++i) {
      f32x2 po = (f32x2){0.f, 0.f};
      const float vv = vS[i * 64 + dv];
      const f32x2 vv2 = (f32x2){vv, vv};
#pragma unroll
      for (int j = 0; j < 8; ++j) {
        const f32x2 fv = *(const f32x2*)(fS + i * 64 + q4 * 16 + 2 * j);
        const f32x2 qv = *(const f32x2*)(qS + i * 64 + q4 * 16 + 2 * j);
        S[j] = fv * (S[j] - vv2) + vv2;
        po = S[j] * qv + po;
      }
      opart[(q4 * 16 + i) * 64 + dv] = po[0] + po[1];
    }
    __syncthreads();
#pragma unroll
    for (int e = 0; e < 4; ++e) {
      const int idx = tid + 256 * e, i = idx >> 6, dvv = idx & 63, tl = sub * 16 + i, s = d ? 63 - tl : tl;
      const float sum = opart[(0 * 16 + i) * 64 + dvv] + opart[(1 * 16 + i) * 64 + dvv] + opart[(2 * 16 + i) * 64 + dvv] + opart[(3 * 16 + i) * 64 + dvv];
      P.obuf[((size_t)d * NTOK + n0 + s) * 256 + h * 64 + dvv] = sum;
    }
  }
}

template <bool OUT>
__device__ void hgrn_mfma_unit(PRef P, int l, int su, char* lds) {
  const int tid = otid(), lane = tid & 63, w = tid >> 6, fr = lane & 15, fq = lane >> 4;
  const int mc = su >> 3, h = (su >> 1) & 3, d = su & 1, n0 = mc * 64;
  const int zfcol = (d == 0 ? 512 : 768) + h * 64;
  __syncthreads();
  {
    const int sub = w;
    char* wl = lds + sub * 10752;
    bf16_t* qa = (bf16_t*)wl;
    bf16_t* qs = qa + 1024;
    bf16_t* ka = qs + 1024;
    bf16_t* kT = ka + 1024;
    bf16_t* vT = kT + 1024;
    float* gS = (float*)(vT + 1024);
    const float lb = lbv(P, l, h * 64 + lane);
    float bc[16], kk[16], vv[16], qq[16];
#pragma unroll
    for (int i = 0; i < 16; ++i) {
      const int tl = sub * 16 + i, st = d ? 63 - tl : tl;
      const bf16_t* zrow = P.z + (size_t)(n0 + st) * 3072;
      kk[i] = bf2f(zrow[zfcol + lane]);
      vv[i] = bf2f(zrow[1024 + h * 64 + lane]);
      if (OUT) qq[i] = bf2f(zrow[256 + h * 64 + lane]);
    }
    {
      float run = 0.f;
#pragma unroll
      for (int i = 0; i < 16; ++i) {
        const float f = lb + (1.f - lb) * sigmoid_(kk[i]);
        run += __logf(f);
        bc[i] = run;
        kk[i] = 1.f - f;
      }
    }
    const float bmid = bc[7], bend = bc[15];
    gS[lane] = __expf(bend);
    {
      u32x4 p0, p1;
      p0.x = pack2(kk[0] * __expf(bend - bc[0]), kk[1] * __expf(bend - bc[1]));
      p0.y = pack2(kk[2] * __expf(bend - bc[2]), kk[3] * __expf(bend - bc[3]));
      p0.z = pack2(kk[4] * __expf(bend - bc[4]), kk[5] * __expf(bend - bc[5]));
      p0.w = pack2(kk[6] * __expf(bend - bc[6]), kk[7] * __expf(bend - bc[7]));
      p1.x = pack2(kk[8] * __expf(bend - bc[8]), kk[9] * __expf(bend - bc[9]));
      p1.y = pack2(kk[10] * __expf(bend - bc[10]), kk[11] * __expf(bend - bc[11]));
      p1.z = pack2(kk[12] * __expf(bend - bc[12]), kk[13] * __expf(bend - bc[13]));
      p1.w = pack2(kk[14] * __expf(bend - bc[14]), kk[15]);
      *(u32x4*)(kT + lane * 16) = p0;
      *(u32x4*)(kT + lane * 16 + 8) = p1;
      p0.x = pack2(vv[0], vv[1]); p0.y = pack2(vv[2], vv[3]); p0.z = pack2(vv[4], vv[5]); p0.w = pack2(vv[6], vv[7]);
      p1.x = pack2(vv[8], vv[9]); p1.y = pack2(vv[10], vv[11]); p1.z = pack2(vv[12], vv[13]); p1.w = pack2(vv[14], vv[15]);
      *(u32x4*)(vT + lane * 16) = p0;
      *(u32x4*)(vT + lane * 16 + 8) = p1;
    }
    if (OUT) {
#pragma unroll
      for (int i = 0; i < 16; ++i) {
        ka[i * 64 + lane] = f2bf(kk[i] * __expf(fminf(bmid - bc[i], 80.f)));
        const float q = silu_(qq[i]);
        qa[i * 64 + lane] = f2bf(q * __expf(fminf(bc[i] - bmid, 80.f)));
        qs[i * 64 + lane] = f2bf(q * __expf(bc[i]));
      }
    }
  }
  __syncthreads();
  const int tn = w;
  f32x4 S[4];
#pragma unroll
  for (int tm = 0; tm < 4; ++tm)
#pragma unroll
    for (int r = 0; r < 4; ++r) S[tm][r] = OUT ? P.sst[((size_t)su * 64 + tm * 16 + fq * 4 + r) * 64 + tn * 16 + fr] : 0.f;
  for (int sub = 0; sub < 4; ++sub) {
    const char* wl = lds + sub * 10752;
    const bf16_t* qa = (const bf16_t*)wl;
    const bf16_t* qs = qa + 1024;
    const bf16_t* ka = qs + 1024;
    const bf16_t* kT = ka + 1024;
    const bf16_t* vT = kT + 1024;
    const float* gS = (const float*)(vT + 1024);
    const u32x2 t2 = *(const u32x2*)(vT + (tn * 16 + fr) * 16 + fq * 4);
    const bf16x8 vb = __builtin_bit_cast(bf16x8, (u32x4){t2.x, t2.y, 0u, 0u});
    if (OUT) {
      f32x4 at = (f32x4){0.f, 0.f, 0.f, 0.f};
#pragma unroll
      for (int ks = 0; ks < 2; ++ks) {
        const bf16x8 a = *(const bf16x8*)(ka + fr * 64 + ks * 32 + fq * 8);
        const bf16x8 b = *(const bf16x8*)(qa + fr * 64 + ks * 32 + fq * 8);
        at = __builtin_amdgcn_mfma_f32_16x16x32_bf16(a, b, at, 0, 0, 0);
      }
#pragma unroll
      for (int r = 0; r < 4; ++r) if (fq * 4 + r > fr) at[r] = 0.f;
      const bf16x8 pa = __builtin_bit_cast(bf16x8, (u32x4){pack2(at[0], at[1]), pack2(at[2], at[3]), 0u, 0u});
      f32x4 o = (f32x4){0.f, 0.f, 0.f, 0.f};
      o = __builtin_amdgcn_mfma_f32_16x16x32_bf16(pa, vb, o, 0, 0, 0);
#pragma unroll
      for (int c = 0; c < 2; ++c) {
        const u32x2 lo = *(const u32x2*)(qs + fr * 64 + (2 * c) * 16 + fq * 4);
        const u32x2 hi = *(const u32x2*)(qs + fr * 64 + (2 * c + 1) * 16 + fq * 4);
        const bf16x8 qsf = __builtin_bit_cast(bf16x8, (u32x4){lo.x, lo.y, hi.x, hi.y});
        const bf16x8 sb = __builtin_bit_cast(bf16x8, (u32x4){pack2(S[2 * c][0], S[2 * c][1]), pack2(S[2 * c][2], S[2 * c][3]),
                                                               pack2(S[2 * c + 1][0], S[2 * c + 1][1]), pack2(S[2 * c + 1][2], S[2 * c + 1][3])});
        o = __builtin_amdgcn_mfma_f32_16x16x32_bf16(qsf, sb, o, 0, 0, 0);
      }
#pragma unroll
      for (int r = 0; r < 4; ++r) {
        const int tl = sub * 16 + fq * 4 + r, st = d ? 63 - tl : tl;
        P.obuf[((size_t)d * NTOK + n0 + st) * 256 + h * 64 + tn * 16 + fr] = o[r];
      }
    }
#pragma unroll
    for (int tm = 0; tm < 4; ++tm) {
      const f32x4 g4 = *(const f32x4*)(gS + tm * 16 + fq * 4);
      const u32x2 k2 = *(const u32x2*)(kT + (tm * 16 + fr) * 16 + fq * 4);
      const bf16x8 kf = __builtin_bit_cast(bf16x8, (u32x4){k2.x, k2.y, 0u, 0u});
      S[tm] = __builtin_amdgcn_mfma_f32_16x16x32_bf16(kf, vb, S[tm] * g4, 0, 0, 0);
    }
  }
  if (!OUT) {
#pragma unroll
    for (int tm = 0; tm < 4; ++tm)
#pragma unroll
      for (int r = 0; r < 4; ++r) P.kv[((size_t)su * 64 + tm * 16 + fq * 4 + r) * 64 + tn * 16 + fr] = S[tm][r];
    if (w == 0) {
      const float g = ((const float*)(lds + 0 * 10752 + 10240))[lane] * ((const float*)(lds + 1 * 10752 + 10240))[lane] *
                      ((const float*)(lds + 2 * 10752 + 10240))[lane] * ((const float*)(lds + 3 * 10752 + 10240))[lane];
      P.gdec[su * 64 + lane] = g;
    }
  }
}

__device__ void hgrn_c_all(PRef P, int l) {
  const int tid = otid(), w = tid >> 6, lane = tid & 63, sub = lane >> 4, d4 = (lane & 15) * 4;
  const f32x4 gn = *(const f32x4*)(P.hg_norm + l * 64 + d4);
  const int stride = gridDim.x * 16;
  for (int p0 = (blockIdx.x * 4 + w) * 4 + sub; p0 < NTOK * 4; p0 += stride * 4) {
    f32x4 val[4]; u32x2 gb[4];
#pragma unroll
    for (int q = 0; q < 4; ++q) {
      const int pi = p0 + q * stride;
      if (pi < NTOK * 4) {
        const int n = pi >> 2, h = pi & 3;
        val[q] = *(const f32x4*)(P.obuf + (size_t)n * 256 + h * 64 + d4) + *(const f32x4*)(P.obuf + ((size_t)NTOK + n) * 256 + h * 64 + d4);
        gb[q] = *(const u32x2*)(P.z + (size_t)n * 3072 + 1280 + h * 64 + d4);
      } else { val[q] = (f32x4){0.f, 0.f, 0.f, 0.f}; gb[q] = (u32x2){0u, 0u}; }
    }
#pragma unroll
    for (int q = 0; q < 4; ++q) {
      const int pi = p0 + q * stride;
      float ss = val[q][0] * val[q][0] + val[q][1] * val[q][1] + val[q][2] * val[q][2] + val[q][3] * val[q][3];
      ss += __shfl_xor(ss, 1); ss += __shfl_xor(ss, 2); ss += __shfl_xor(ss, 4); ss += __shfl_xor(ss, 8);
      if (pi < NTOK * 4) {
        const int n = pi >> 2, h = pi & 3;
        const float rs = rsqrtf(ss * (1.f / 64.f) + 1e-6f);
        const float g0 = bf2f((bf16_t)(gb[q].x & 0xffff)), g1 = bf2f((bf16_t)(gb[q].x >> 16)), g2 = bf2f((bf16_t)(gb[q].y & 0xffff)), g3 = bf2f((bf16_t)(gb[q].y >> 16));
        uint2 o;
        o.x = pack2(val[q][0] * rs * gn[0] * silu_(g0), val[q][1] * rs * gn[1] * silu_(g1));
        o.y = pack2(val[q][2] * rs * gn[2] * silu_(g2), val[q][3] * rs * gn[3] * silu_(g3));
        *(uint2*)(P.mix + blk_off(n, 256 + h * 64 + d4, 1024)) = o;
      }
    }
  }
}

__device__ void carry_phase(PRef P, int l) {
  const size_t gtid = (size_t)blockIdx.x * 256 + otid(), gsz = (size_t)gridDim.x * 256;
  for (size_t e = gtid; e < (size_t)18 * 4 * 2 * 4096; e += gsz) {
    const int dv = (int)(e & 63), dk = (int)((e >> 6) & 63), d = (int)((e >> 12) & 1), h = (int)((e >> 13) & 3), bb = (int)(e >> 15);
    int mcb, nc; float S;
    if (bb < 16) { mcb = bb * 4; nc = 4; S = 0.f; }
    else { mcb = 64 + (bb - 16) * 16; nc = 16; S = P.state_hgrn[((((size_t)((bb - 16) * 2 + l) * 2 + d) * 4 + h) * 64 + dk) * 64 + dv]; }
    for (int c0 = 0; c0 < nc; c0 += 4) {
      float gq[4], kq[4];
#pragma unroll
      for (int q = 0; q < 4; ++q) {
        const int cc = c0 + q, c = d ? nc - 1 - cc : cc;
        const size_t u = (size_t)((mcb + c) * 4 + h) * 2 + d;
        gq[q] = P.gdec[u * 64 + dk]; kq[q] = P.kv[(u * 64 + dk) * 64 + dv];
      }
#pragma unroll
      for (int q = 0; q < 4; ++q) {
        const int cc = c0 + q, c = d ? nc - 1 - cc : cc;
        const size_t u = (size_t)((mcb + c) * 4 + h) * 2 + d;
        P.sst[(u * 64 + dk) * 64 + dv] = S;
        S = gq[q] * S + kq[q];
      }
    }
    if (bb < 16) P.out[OUT_HG + ((((size_t)(bb * 2 + l) * 2 + d) * 4 + h) * 64 + dk) * 64 + dv] = S;
  }
  for (size_t e = gtid; e < (size_t)18 * 16 * 2 * 64; e += gsz) {
    const int p = (int)(e & 63), d = (int)((e >> 6) & 1), g = (int)((e >> 7) & 15), bb = (int)(e >> 11);
    const int ldg = (l * 2 + d) * 16 + g;
    int cb, nc; float sr, si;
    if (bb < 16) { cb = bb * 8; nc = 8; sr = 0.f; si = 0.f; }
    else {
      cb = 128 + (bb - 16) * 32; nc = 32;
      const float* sp = P.state_s5 + (((((size_t)((bb - 16) * 2 + l) * 2 + d) * 16 + g) * 64 + p) * 2);
      sr = sp[0]; si = sp[1];
    }
    const float2 aT = P.apow[((size_t)ldg * 64 + p) * 33 + 32];
    for (int c0 = 0; c0 < nc; c0 += 8) {
      f32x2 eq[8];
#pragma unroll
      for (int q = 0; q < 8; ++q) {
        const int cc = c0 + q, c = d ? nc - 1 - cc : cc;
        eq[q] = *(const f32x2*)(P.E + ((size_t)(g * 192 + cb + c)) * 256 + d * 128 + p * 2);
      }
#pragma unroll
      for (int q = 0; q < 8; ++q) {
        const int cc = c0 + q, c = d ? nc - 1 - cc : cc;
        *(unsigned*)(P.bts5 + (size_t)g * 256 * 768 + blk_off(cb + c, 512 + d * 128 + p * 2, 768)) = pack2(sr, si);
        const float nr = aT.x * sr - aT.y * si + eq[q][0], ni = aT.x * si + aT.y * sr + eq[q][1];
        sr = nr; si = ni;
      }
    }
    if (bb < 16) {
      const float* ur = P.uedge + (size_t)(bb * 2 + d) * 256 + g * 16;
      float fr_ = 0.f, fi_ = 0.f;
#pragma unroll
      for (int hh = 0; hh < 16; ++hh) {
        const float2 bv = P.bbar[((size_t)ldg * 64 + p) * 16 + hh];
        fr_ += ur[hh] * bv.x; fi_ += ur[hh] * bv.y;
      }
      float* op = P.out + OUT_S5 + (((((size_t)(bb * 2 + l) * 2 + d) * 16 + g) * 64 + p) * 2);
      op[0] = fr_; op[1] = fi_;
    }
  }
}

__device__ __forceinline__ int snake_unit(int pass, int G) { return pass * G + ((pass & 1) ? (G - 1 - (int)blockIdx.x) : (int)blockIdx.x); }
__device__ void mixa_phase(PRef P, int l, char* lds) {
  const int G = gridDim.x, bid = blockIdx.x;
  for (int pass = 0; pass < 3 || (G != 768 && pass * G < 1600); ++pass) {
    int u;
    if (G == 768) {
      if (bid < 256) u = (pass == 0) ? bid : -1;
      else {
        const int j = bid - 256;
        if (pass == 0) u = 1024 + j;
        else if (pass == 1) u = 256 + j;
        else u = (j < 256) ? 256 + 512 + j : (j < 320 ? 1536 + (j - 256) : -1);
      }
    } else {
      u = pass * G + bid;
      if (u >= 1600) u = -1;
    }
    if (u < 0) continue;
    if (u < 256 || (u >= 1024 && u < 1536)) attn_unit(P, l, u < 256 ? u : u - 768, lds);
    else if (u < 1024) hgrn_mfma_unit<false>(P, l, u - 256, lds);
    else s5e_unit(P, l, u - 1536, lds);
  }
}
__device__ void mixb_phase(PRef P, int l, char* lds) {
  for (int u = blockIdx.x; u < 768 + 256; u += gridDim.x) {
    if (u < 768) hgrn_mfma_unit<true>(P, l, u, lds);
    else s5y_unit(P, l, u - 768, lds);
  }
}
__device__ void gluc_phase(PRef P, int l, char* lds) {
  for (int u = blockIdx.x; u < 96; u += gridDim.x) glu_unit(P, l, u, lds);
  hgrn_c_all(P, l);
}

#define XB_TMO      128
#define XB_XCNT(j)  (256  + 64 * (j))
#define XB_XSUB(j)  (1280 + 64 * (j))
#define XB_XGEN(j)  (2304 + 64 * (j))
#define XB_TOP      3328
#define XB_TOPGEN   3392
#define XCD_BAR_WORDS 3456
#define XB_SPIN_CAP (1u << 18)
#define LAS __attribute__((address_space(3)))
__device__ __forceinline__ unsigned xb_ld(unsigned* p)              { return __hip_atomic_load(p, __ATOMIC_RELAXED, __HIP_MEMORY_SCOPE_AGENT); }
__device__ __forceinline__ unsigned xb_add(unsigned* p, unsigned v) { return __hip_atomic_fetch_add(p, v, __ATOMIC_RELAXED, __HIP_MEMORY_SCOPE_AGENT); }
__device__ __forceinline__ unsigned xb_xcc_id() { return (unsigned)__builtin_amdgcn_s_getreg((3 << 11) | 20) & 0xFu; }
#define XB_SPIN(cond, bar) do { unsigned _sp = 0; while (cond) { __builtin_amdgcn_s_sleep(1); \
    if ((++_sp & 255u) == 0u) { if (xb_ld(&(bar)[XB_TMO])) break; if (_sp > XB_SPIN_CAP) { atomicAdd(&(bar)[XB_TMO], 1u); break; } } } } while (0)
struct XcdBarrier { unsigned* bar; unsigned x; volatile LAS unsigned* st; };
__device__ __forceinline__ XcdBarrier xcd_barrier_post(unsigned* bar, volatile LAS unsigned* st) {
    XcdBarrier b; b.bar = bar; b.x = xb_xcc_id(); b.st = st;
    if (threadIdx.x == 0) (void)xb_add(&bar[XB_XCNT(b.x)], 1u);
    return b;
}
__device__ __forceinline__ void xcd_barrier_complete(unsigned* bar, unsigned x, unsigned& nloc, unsigned& nx) {
    const unsigned G = gridDim.x * gridDim.y * gridDim.z;
    unsigned sum, cnt, mine, sp = 0u;
    for (;;) {
        sum = 0u; cnt = 0u; mine = 0u;
#pragma unroll
        for (unsigned j = 0; j < 16; ++j) { const unsigned c = xb_ld(&bar[XB_XCNT(j)]); sum += c; cnt += (c > 0u) ? 1u : 0u; mine = (j == x) ? c : mine; }
        if (sum == G) break;
        __builtin_amdgcn_s_sleep(1);
        if ((++sp & 255u) == 0u) { if (xb_ld(&bar[XB_TMO])) break; if (sp > XB_SPIN_CAP) { atomicAdd(&bar[XB_TMO], 1u); break; } }
    }
    nloc = mine > 0u ? mine : 1u; nx = cnt > 0u ? cnt : 1u;
}
template <bool INV>
__device__ __forceinline__ void xcd_barrier(const XcdBarrier& b) {
    asm volatile("s_waitcnt vmcnt(0)" ::: "memory");
    __syncthreads();
    if (threadIdx.x == 0) {
        unsigned* bar = b.bar;
        __builtin_amdgcn_s_waitcnt(0);
        unsigned nloc = b.st[0], nx = b.st[1];
        if (nloc == 0u) { xcd_barrier_complete(bar, b.x, nloc, nx); b.st[0] = nloc; b.st[1] = nx; }
        const unsigned old = xb_add(&bar[XB_XSUB(b.x)], 1u);
        const unsigned gen = old / nloc;
        if (old + 1u == (gen + 1u) * nloc) {
            __builtin_amdgcn_fence(__ATOMIC_RELEASE, "agent");
            asm volatile("s_waitcnt vmcnt(0)" ::: "memory");
            const unsigned og = xb_add(&bar[XB_TOP], 1u);
            const unsigned tg = og / nx;
            if (og + 1u == (tg + 1u) * nx) xb_add(&bar[XB_TOPGEN], 1u);
            else XB_SPIN(xb_ld(&bar[XB_TOPGEN]) == tg, bar);
            if (INV) __builtin_amdgcn_fence(__ATOMIC_ACQUIRE, "agent");
            xb_add(&bar[XB_XGEN(b.x)], 1u);
            asm volatile("s_waitcnt vmcnt(0)" ::: "memory");
        } else {
            XB_SPIN(xb_ld(&bar[XB_XGEN(b.x)]) == gen, bar);
            if (INV) __builtin_amdgcn_fence(__ATOMIC_ACQUIRE, "agent");
            asm volatile("s_waitcnt vmcnt(0)" ::: "memory");
        }
    }
    __syncthreads();
}

template <int S>
__device__ __forceinline__ void run_step(PRef P, int l, char* lds) {
  if constexpr (S == 0) phase0a(P, lds);
  else if constexpr (S == 1) phase0b(P);
  else if constexpr (S == 2) normmod_phase(P, l, 0);
  else if constexpr (S == 3) win_phase(P, l, lds);
  else if constexpr (S == 4) mixa_phase(P, l, lds);
  else if constexpr (S == 5) carry_phase(P, l);
  else if constexpr (S == 6) mixb_phase(P, l, lds);
  else if constexpr (S == 7) gluc_phase(P, l, lds);
  else if constexpr (S == 8) wout_phase(P, l, lds);
  else if constexpr (S == 9) normmod_phase(P, l, 1);
  else if constexpr (S == 10) mlp1_phase(P, l, lds);
  else if constexpr (S == 11) mlp2_phase(P, l, lds);
  else if constexpr (S == 13) mlp2_phase<true>(P, l, lds);
  else if constexpr (S == 15) mlp1_dummy_phase<true>(P, l, lds);
  else if constexpr (S == 16) mlp1_dummy_phase<false>(P, l, lds);
  else if constexpr (S == 14) wout_phase<true>(P, l, lds);
  else final_phase(P);
}

#if ONE_LAUNCH
__device__ __forceinline__ PPtr kparams() {
  PPtr pp = (PPtr)__builtin_amdgcn_kernarg_segment_ptr();
  asm volatile("" : "+s"(pp));
  return pp;
}
#define RUN(S_, l_) run_step<S_>(*kparams(), l_, lds)
__global__ void __launch_bounds__(256, 3) mega(Params Pv) {
  __shared__ __attribute__((aligned(16))) char lds[45056];
  __shared__ uint4 xb_words;
  if (threadIdx.x == 0) xb_words = make_uint4(0u, 0u, 0u, 0u);
  __syncthreads();
  (void)xcd_barrier_post(kparams()->bar, (volatile LAS unsigned*)&xb_words);
#define GSYNC_(INV_) do { XcdBarrier xb_; xb_.bar = kparams()->bar; xb_.x = xb_xcc_id(); xb_.st = (volatile LAS unsigned*)&xb_words; xcd_barrier<INV_>(xb_); } while (0)
#define GSYNC() GSYNC_(false)
#define GSYNCI() GSYNC_(true)
  RUN(0, 0);
  if (kparams()->use_cg) cg::this_grid().sync();
  GSYNC();
#pragma nounroll
  for (int l = 0; l < 2; ++l) {
    RUN(2, l); GSYNC();
    RUN(3, l); GSYNCI();
    RUN(4, l); GSYNC();
    RUN(5, l); GSYNC();
    RUN(6, l); GSYNC();
    RUN(7, l); GSYNC();
    RUN(8, l); GSYNC();
    RUN(9, l); GSYNC();
    RUN(10, l); GSYNCI();
    RUN(11, l); GSYNC();
  }
  RUN(12, 0);
}
#else
template <int S>
__global__ void __launch_bounds__(256, 2) step_kernel(Params Pv, int l) {
  __shared__ __attribute__((aligned(16))) char lds[45056];
  run_step<S>(*(PPtr)__builtin_amdgcn_kernarg_segment_ptr(), l, lds);
}
#endif

extern "C" void kernel_launch(void* const* d_in, const int* in_sizes, int n_in, void* d_out, int out_size, void* d_ws, size_t ws_size,
                              hipStream_t stream) {
  Params P{};
  const float** pin = (const float**)&P;
  for (int i = 0; i < 30; ++i) pin[i] = (const float*)d_in[i];
  P.out = (float*)d_out;
  char* ws = (char*)d_ws;
  size_t off = 0;
  auto alloc = [&](size_t bytes) { char* p = ws + off; off += (bytes + 255) & ~(size_t)255; return p; };
  P.wt_in = (bf16_t*)alloc((size_t)2 * 3072 * 1024 * 2);
  P.wt_out = (bf16_t*)alloc((size_t)2 * 1024 * 1024 * 2);
  P.wt_m1 = (bf16_t*)alloc((size_t)2 * 4096 * 1024 * 2);
  P.wt_m2 = (bf16_t*)alloc((size_t)2 * 4096 * 1024 * 2);
  P.wt_glu = (bf16_t*)alloc((size_t)2 * 256 * 256 * 2);
  P.adap = (float*)alloc((size_t)2 * 16 * 3 * 6144 * 4);
  P.uedge = (float*)alloc((size_t)16 * 2 * 256 * 4);
  P.z = (bf16_t*)alloc((size_t)NTOK * 4096 * 2);
  P.hid = P.z;
  P.h = (bf16_t*)alloc((size_t)NTOK * 1024 * 2);
  P.mix = (bf16_t*)alloc((size_t)NTOK * 1024 * 2);
  P.xg = (bf16_t*)alloc((size_t)NTOK * 256 * 2);
  P.ckb = (bf16_t*)alloc((size_t)2 * 2 * 512 * 512 * 2);
  P.cvb = (bf16_t*)alloc((size_t)2 * 2 * 512 * 512 * 2);
  P.apow = (float2*)alloc((size_t)64 * 64 * 33 * 8);
  P.bbar = (float2*)alloc((size_t)64 * 64 * 16 * 8);
  P.ktab = (float*)alloc((size_t)64 * 8192 * 4);
  P.atab = (bf16_t*)alloc((size_t)32 * 512 * 768 * 2);
  P.wtab = (bf16_t*)alloc((size_t)32 * 256 * 512 * 2);
  P.bts5 = (bf16_t*)alloc((size_t)16 * 256 * 768 * 2);
  P.E = (float*)alloc((size_t)16 * 256 * 192 * 4);
  P.kv = (float*)alloc((size_t)768 * 4096 * 4);
  P.gdec = (float*)alloc((size_t)768 * 64 * 4);
  P.sst = (float*)alloc((size_t)768 * 4096 * 4);
  P.obuf = (float*)alloc((size_t)2 * NTOK * 256 * 4);
  P.pbuf = P.kv;
  P.bar = (unsigned*)alloc((size_t)XCD_BAR_WORDS * 4);
  P.mod = (float*)alloc((size_t)2 * 3 * 6144 * 4);
  const size_t zero_bytes = (size_t)((char*)P.mod - (char*)P.bar) + (size_t)2 * 3 * 6144 * 4;
  if (off > ws_size) { fprintf(stderr, "workspace too small: need %zu have %zu\n", off, ws_size); return; }

#if ONE_LAUNCH
  static int grid_blocks = 0;
  if (!grid_blocks) {
    int dev = 0, cus = 0, per_cu = 0;
    (void)hipGetDevice(&dev);
    (void)hipDeviceGetAttribute(&cus, hipDeviceAttributeMultiprocessorCount, dev);
    (void)hipOccupancyMaxActiveBlocksPerMultiprocessor(&per_cu, mega, 256, 0);
    if (per_cu < 1) per_cu = 1;
    if (per_cu > 4) per_cu = 4;
    grid_blocks = cus * per_cu;
  }
  (void)hipMemsetAsync(P.bar, 0, zero_bytes, stream);
  void* args[] = {&P};
  hipError_t e = hipLaunchCooperativeKernel((void*)mega, dim3(grid_blocks), dim3(256), args, 0, stream);
  if (e != hipSuccess) fprintf(stderr, "cooperative launch failed: %s (grid %d)\n", hipGetErrorString(e), grid_blocks);
#else
  const int grid_blocks = 512;
  step_kernel<0><<<grid_blocks, 256, 0, stream>>>(P, 0);
  step_kernel<1><<<grid_blocks, 256, 0, stream>>>(P, 0);
  for (int l = 0; l < 2; ++l) {
    step_kernel<2><<<grid_blocks, 256, 0, stream>>>(P, l);
    step_kernel<3><<<grid_blocks, 256, 0, stream>>>(P, l);
    step_kernel<4><<<grid_blocks, 256, 0, stream>>>(P, l);
    step_kernel<5><<<grid_blocks, 256, 0, stream>>>(P, l);
    step_kernel<6><<<grid_blocks, 256, 0, stream>>>(P, l);
    step_kernel<7><<<grid_blocks, 256, 0, stream>>>(P, l);
    step_kernel<8><<<grid_blocks, 256, 0, stream>>>(P, l);
    step_kernel<9><<<grid_blocks, 256, 0, stream>>>(P, l);
    step_kernel<10><<<grid_blocks, 256, 0, stream>>>(P, l);
    step_kernel<11><<<grid_blocks, 256, 0, stream>>>(P, l);
  }
  step_kernel<12><<<grid_blocks, 256, 0, stream>>>(P, 0);
#endif
}
```

```cpp
#include <hip/hip_runtime.h>
#include <hip/hip_cooperative_groups.h>
#include <cstdio>
#include <cstdint>
namespace cg = cooperative_groups;

#ifndef ONE_LAUNCH
#define ONE_LAUNCH 1
#endif

typedef unsigned short bf16_t;
typedef short bf16x8 __attribute__((ext_vector_type(8)));
typedef float f32x4 __attribute__((ext_vector_type(4)));
typedef unsigned u32x4 __attribute__((ext_vector_type(4)));
typedef unsigned u32x2 __attribute__((ext_vector_type(2)));
typedef float f32x2 __attribute__((ext_vector_type(2)));

#define NTOK 6144
#define NCTX 4096
#define NPHASE 23

struct Params {
  const float *x_prompt, *x_sample, *cache_k, *cache_v, *state_s5, *state_hgrn, *c, *c_ctx;
  const float *w_ada, *b_ada, *norm_mix, *norm_mlp, *w_in, *w_out;
  const float *s5_a_re, *s5_a_im, *s5_b_re, *s5_b_im, *s5_c_re, *s5_c_im, *s5_log_dt, *s5_d, *s5_w_glu, *s5_b_glu;
  const float *hg_lb, *hg_norm, *na_rpb, *w_mlp1, *w_mlp2, *norm_final;
  float* out;
  bf16_t *wt_in, *wt_out, *wt_m1, *wt_m2, *wt_glu;
  float *adap, *mod, *uedge;
  bf16_t* z;
  bf16_t *h, *mix, *hid, *xg, *ckb, *cvb;
  float2 *apow, *bbar;
  float* ktab;
  bf16_t *atab, *wtab, *bts5;
  float* E;
  float *kv, *gdec, *sst, *obuf, *pbuf;
  unsigned* bar;
  int use_cg, pad_;
};

typedef const __attribute__((address_space(4))) Params& PRef;
typedef const __attribute__((address_space(4))) Params* PPtr;

#define OUT_CK 6291456
#define OUT_CV 10485760
#define OUT_S5 14680064
#define OUT_HG 14811136

__device__ __forceinline__ int otid() { int t = (int)__builtin_amdgcn_workitem_id_x(); asm volatile("" : "+v"(t)); return t; }
__device__ __forceinline__ bf16_t f2bf(float f) {
  unsigned u = __float_as_uint(f);
  u += 0x7fffu + ((u >> 16) & 1u);
  return (bf16_t)(u >> 16);
}
__device__ __forceinline__ unsigned pack2(float a, float b) { return (unsigned)f2bf(a) | ((unsigned)f2bf(b) << 16); }
__device__ __forceinline__ float bf2f(bf16_t b) { return __uint_as_float(((unsigned)b) << 16); }
__device__ __forceinline__ float sigmoid_(float x) { return 1.f / (1.f + __expf(-x)); }
__device__ __forceinline__ float silu_(float x) { return x * sigmoid_(x); }
__device__ __forceinline__ float gelu_tanh(float y) {
  float t = 0.7978845608028654f * (y + 0.044715f * y * y * y);
  float th = 1.f - 2.f / (__expf(2.f * t) + 1.f);
  return 0.5f * y * (1.f + th);
}
__device__ __forceinline__ float wave_sum(float v) {
#pragma unroll
  for (int o = 32; o > 0; o >>= 1) v += __shfl_xor(v, o);
  return v;
}
__device__ __forceinline__ int variant_of(int n) { return n < NCTX ? 0 : 1 + ((n - NCTX) >> 10); }
__device__ __forceinline__ float lbv(PRef P, int l, int c) {
  if (l == 0) return 0.f;
  float x0 = P.hg_lb[c], x1 = P.hg_lb[256 + c];
  return 1.f / (1.f + __expf(x0 - x1));
}

__device__ __forceinline__ size_t blk_off(int r, int k, int K) {
  return ((size_t)(r >> 7) * (size_t)(K >> 5) + (size_t)(k >> 5)) * 4096 + (size_t)((r & 127) * 32 + (k & 31));
}
template <int NI = 4, bool HOT = false, bool PERM = false, class Epi>
__device__ __forceinline__ void gemm_tile(const bf16_t* __restrict__ A, const bf16_t* __restrict__ B, int nk,
                                          char* lds, Epi epi) {
  const int tid = otid(), lane = tid & 63, w = tid >> 6, wr = w >> 1, wc = w & 1, fr = lane & 15, fq = lane >> 4;
  constexpr int NB = NI / 2;
  f32x4 acc[4][NI];
#pragma unroll
  for (int i = 0; i < 4; ++i)
#pragma unroll
    for (int j = 0; j < NI; ++j) acc[i][j] = (f32x4){0.f, 0.f, 0.f, 0.f};
  u32x4 ra[2], rb[NB];
  const int wsw = (0x1320 >> ((((tid >> 2) >> 2) & 3) * 4)) & 3;
  const int loff0 = (tid >> 2) * 64 + (((tid & 3) ^ wsw) << 4);
  const int rsw = (0x1320 >> (((fr >> 2) & 3) * 4)) & 3;
  const int aoff = (wr * 64 + fr) * 64 + ((fq ^ rsw) << 4);
  const int boff = 8192 + (wc * (16 * NI) + fr) * 64 + ((fq ^ rsw) << 4);
  const bf16_t* Ap = A + tid * 8;
  const bf16_t* Bp = B + tid * 8;
#define GT_LOAD()                                                                          \
  {                                                                                        \
    _Pragma("unroll") for (int i = 0; i < 2; ++i) ra[i] = *(const u32x4*)(Ap + 2048 * i);  \
    _Pragma("unroll") for (int i = 0; i < NB; ++i) rb[i] = *(const u32x4*)(Bp + 2048 * i); \
  }
#define GT_STORE(buf_)                                                                                         \
  {                                                                                                            \
    _Pragma("unroll") for (int i = 0; i < 2; ++i) *(u32x4*)(lds + (buf_) * 16384 + loff0 + 4096 * i) = ra[i];  \
    _Pragma("unroll") for (int i = 0; i < NB; ++i) *(u32x4*)(lds + (buf_) * 16384 + 8192 + loff0 + 4096 * i) = rb[i]; \
  }
  __syncthreads();
  GT_LOAD();
  GT_STORE(0);
  if (nk > 1) { if (!HOT) { Ap += 4096; Bp += 4096; } GT_LOAD(); }
  __syncthreads();
  for (int kt = 0; kt < nk; ++kt) {
    const int cur = kt & 1;
    if (kt + 1 < nk) GT_STORE(cur ^ 1);
    if (kt + 2 < nk) { if (!HOT) { Ap += 4096; Bp += 4096; } GT_LOAD(); }
    __builtin_amdgcn_sched_barrier(0);
    {
      const char* sb = lds + cur * 16384;
      bf16x8 af[4], bfr[NI];
#pragma unroll
      for (int mi = 0; mi < 4; ++mi) af[mi] = *(const bf16x8*)(sb + aoff + 1024 * mi);
#pragma unroll
      for (int ni = 0; ni < NI; ++ni) bfr[ni] = *(const bf16x8*)(sb + boff + 1024 * ni);
#pragma unroll
      for (int mi = 0; mi < 4; ++mi)
#pragma unroll
        for (int ni = 0; ni < NI; ++ni)
          acc[mi][ni] = __builtin_amdgcn_mfma_f32_16x16x32_bf16(bfr[ni], af[mi], acc[mi][ni], 0, 0, 0);
    }
    __syncthreads();
  }
  if constexpr (PERM) {
#pragma unroll
    for (int mi = 0; mi < 4; ++mi)
#pragma unroll
      for (int k = 0; k < NI / 2; ++k) epi(wr * 64 + mi * 16 + fr, wc * (16 * NI) + k * 32 + fq * 8, acc[mi][2 * k], acc[mi][2 * k + 1]);
  } else {
#pragma unroll
    for (int mi = 0; mi < 4; ++mi)
#pragma unroll
      for (int ni = 0; ni < NI; ++ni) epi(wr * 64 + mi * 16 + fr, wc * (16 * NI) + ni * 16 + fq * 4, acc[mi][ni]);
  }
}

__device__ void transpose_tile(const float* __restrict__ src, bf16_t* __restrict__ dst, int K, int N, int t, char* lds) {
  float* T = (float*)lds;
  const int tid = otid();
  const int ntn = N >> 6, kt = t / ntn, nt = t % ntn;
  __syncthreads();
#pragma unroll
  for (int i = 0; i < 4; ++i) {
    const int idx = tid + 256 * i, kr = idx >> 4, n4 = idx & 15;
    const float4 v = *(const float4*)(src + (size_t)(kt * 64 + kr) * N + nt * 64 + n4 * 4);
    T[kr * 65 + n4 * 4 + 0] = v.x; T[kr * 65 + n4 * 4 + 1] = v.y; T[kr * 65 + n4 * 4 + 2] = v.z; T[kr * 65 + n4 * 4 + 3] = v.w;
  }
  __syncthreads();
#pragma unroll
  for (int i = 0; i < 2; ++i) {
    const int idx = tid + 256 * i, n = idx >> 3, kc = idx & 7;
    uint4 o;
    o.x = pack2(T[(kc * 8 + 0) * 65 + n], T[(kc * 8 + 1) * 65 + n]);
    o.y = pack2(T[(kc * 8 + 2) * 65 + n], T[(kc * 8 + 3) * 65 + n]);
    o.z = pack2(T[(kc * 8 + 4) * 65 + n], T[(kc * 8 + 5) * 65 + n]);
    o.w = pack2(T[(kc * 8 + 6) * 65 + n], T[(kc * 8 + 7) * 65 + n]);
    const int cfull = nt * 64 + n, c32 = cfull & 31, rho = ((c32 >> 2) & 1) * 16 + (c32 >> 3) * 4 + (c32 & 3);
    *(uint4*)(dst + blk_off((cfull & ~31) + rho, kt * 64 + kc * 8, K)) = o;
  }
}

__device__ void ada_unit(PRef P, int u, char* lds) {
  float* sv = (float*)lds;
  const int tid = otid();
  const int l = u / 384, r = u % 384, jb = r / 16, ks = r % 16;
  __syncthreads();
  if (tid < 192) {
    const int v = tid >> 6, k = ks * 64 + (tid & 63);
    const float cv = (v == 0) ? P.c_ctx[k] : P.c[(v - 1) * 1024 + k];
    sv[tid] = silu_(cv);
  }
  __syncthreads();
  const int j = jb * 256 + tid;
  const float* wp = P.w_ada + ((size_t)l * 1024 + ks * 64) * 6144 + j;
  float a0 = 0.f, a1 = 0.f, a2 = 0.f;
#pragma unroll 8
  for (int k = 0; k < 64; ++k) {
    const float wv = wp[(size_t)k * 6144];
    a0 += sv[k] * wv; a1 += sv[64 + k] * wv; a2 += sv[128 + k] * wv;
  }
  if (ks == 0) { const float bj = P.b_ada[l * 6144 + j]; a0 += bj; a1 += bj; a2 += bj; }
  float* mp = P.mod + (size_t)(l * 3) * 6144 + j;
  __hip_atomic_fetch_add(mp, a0, __ATOMIC_RELAXED, __HIP_MEMORY_SCOPE_AGENT);
  __hip_atomic_fetch_add(mp + 6144, a1, __ATOMIC_RELAXED, __HIP_MEMORY_SCOPE_AGENT);
  __hip_atomic_fetch_add(mp + 2 * 6144, a2, __ATOMIC_RELAXED, __HIP_MEMORY_SCOPE_AGENT);
}

__device__ void s5pre_unit(PRef P, int u, char* lds) {
  float2* apw = (float2*)lds;
  float2* bb = apw + 64 * 33;
  float2* cc = bb + 64 * 16;
  const int tid = otid();
  const int ldg = u >> 2, part = u & 3;
  __syncthreads();
  {
    const int p = tid & 63, q = tid >> 6;
    const float are = P.s5_a_re[ldg * 64 + p], aim = P.s5_a_im[ldg * 64 + p];
    const float dt = expf(P.s5_log_dt[ldg]);
    for (int k = q; k < 10; k += 4) {
      const int tau = (k < 8) ? part * 8 + k : (k == 8 ? 1 : 32);
      const float mag = expf((float)tau * are * dt);
      const float ang = (float)tau * aim * dt;
      float sn, cs;
      sincosf(ang, &sn, &cs);
      const float2 v = make_float2(mag * cs, mag * sn);
      apw[p * 33 + tau] = v;
      if (k < 8 || (k == 9 && part == 3)) P.apow[((size_t)ldg * 64 + p) * 33 + tau] = v;
    }
  }
  __syncthreads();
  for (int e = tid; e < 1024; e += 256) {
    const int p = e >> 4, hh = e & 15;
    const float are = P.s5_a_re[ldg * 64 + p], aim = P.s5_a_im[ldg * 64 + p];
    const float2 ab = apw[p * 33 + 1];
    const float nr = ab.x - 1.f, ni = ab.y, den = are * are + aim * aim;
    const float cr = (nr * are + ni * aim) / den, ci = (ni * are - nr * aim) / den;
    const float br = P.s5_b_re[((size_t)ldg * 64 + p) * 16 + hh], bi = P.s5_b_im[((size_t)ldg * 64 + p) * 16 + hh];
    const float2 v = make_float2(cr * br - ci * bi, cr * bi + ci * br);
    bb[p * 16 + hh] = v;
    if (part == 0) P.bbar[((size_t)ldg * 64 + p) * 16 + hh] = v;
    const int h2 = e >> 6, p2 = e & 63;
    cc[h2 * 64 + p2] = make_float2(P.s5_c_re[((size_t)ldg * 16 + h2) * 64 + p2], P.s5_c_im[((size_t)ldg * 16 + h2) * 64 + p2]);
  }
  __syncthreads();
  for (int e = tid; e < 2048; e += 256) {
    const int tau = part * 8 + (e >> 8), hh = (e >> 4) & 15, h2 = e & 15;
    float s = 0.f;
    for (int p = 0; p < 64; ++p) {
      const float2 c = cc[hh * 64 + p], a = apw[p * 33 + tau], b = bb[p * 16 + h2];
      const float tr = a.x * b.x - a.y * b.y, ti = a.x * b.y + a.y * b.x;
      s += c.x * tr - c.y * ti;
    }
    P.ktab[(size_t)ldg * 8192 + tau * 256 + (e & 255)] = s;
  }
}

struct TrDesc { const float* src; bf16_t* dst; int K, N, tile; };
__device__ __forceinline__ TrDesc tr_decode(PRef P, int u) {
  TrDesc D;
  if (u < 2048) { const int l = u >> 10; D.src = P.w_mlp1 + (size_t)l * 1024 * 4096; D.dst = P.wt_m1 + (size_t)l * 4096 * 1024; D.K = 1024; D.N = 4096; D.tile = u & 1023; return D; }
  u -= 2048;
  if (u < 2048) { const int l = u >> 10; D.src = P.w_mlp2 + (size_t)l * 4096 * 1024; D.dst = P.wt_m2 + (size_t)l * 1024 * 4096; D.K = 4096; D.N = 1024; D.tile = u & 1023; return D; }
  u -= 2048;
  if (u < 1536) { const int l = u / 768; D.src = P.w_in + (size_t)l * 1024 * 3072; D.dst = P.wt_in + (size_t)l * 3072 * 1024; D.K = 1024; D.N = 3072; D.tile = u % 768; return D; }
  u -= 1536;
  if (u < 512) { const int l = u >> 8; D.src = P.w_out + (size_t)l * 1024 * 1024; D.dst = P.wt_out + (size_t)l * 1024 * 1024; D.K = 1024; D.N = 1024; D.tile = u & 255; return D; }
  u -= 512;
  { const int l = u >> 4; D.src = P.s5_w_glu + (size_t)l * 256 * 256; D.dst = P.wt_glu + (size_t)l * 256 * 256; D.K = 256; D.N = 256; D.tile = u & 15; return D; }
}
#define TR_NTILES 6176
#define TR_LOAD(r_, D_)                                                                                        \
  {                                                                                                            \
    const int ntn_ = (D_).N >> 6, kt_ = (D_).tile / ntn_, nt_ = (D_).tile % ntn_;                              \
    _Pragma("unroll") for (int i = 0; i < 4; ++i) {                                                            \
      const int idx = tid + 256 * i, kr = idx >> 4, n4 = idx & 15;                                             \
      r_[i] = *(const f32x4*)((D_).src + (size_t)(kt_ * 64 + kr) * (D_).N + nt_ * 64 + n4 * 4);               \
    }                                                                                                          \
  }

__device__ void phase0a(PRef P, char* lds) {
  const int tid = otid();
  const int G = gridDim.x;
  for (int u0 = blockIdx.x; u0 < 256 + 768 + 128; u0 += G) {
    int u = u0;
    if (u < 256) { s5pre_unit(P, u, lds); continue; }
    u -= 256;
    if (u < 768) { ada_unit(P, u, lds); continue; }
    u -= 768;
    {
      const int c = u, which = c >> 6;
      const float* src = (which ? P.cache_v : P.cache_k) + (size_t)(c & 63) * 16384;
      bf16_t* dst = (which ? P.cvb : P.ckb) + (size_t)(c & 63) * 16384;
#pragma unroll
      for (int i = 0; i < 8; ++i) {
        const int e = (tid + 256 * i) * 8;
        const f32x4 a = *(const f32x4*)(src + e), b = *(const f32x4*)(src + e + 4);
        u32x4 o; o.x = pack2(a[0], a[1]); o.y = pack2(a[2], a[3]); o.z = pack2(b[0], b[1]); o.w = pack2(b[2], b[3]);
        *(u32x4*)(dst + e) = o;
      }
    }
  }
  float* T = (float*)lds;
  int t = blockIdx.x;
  f32x4 r[4], rn[4];
  TrDesc D = tr_decode(P, t < TR_NTILES ? t : 0), Dn = D;
  if (t < TR_NTILES) TR_LOAD(r, D);
  while (t < TR_NTILES) {
    const int tn = t + G;
    if (tn < TR_NTILES) { Dn = tr_decode(P, tn); TR_LOAD(rn, Dn); }
    __syncthreads();
#pragma unroll
    for (int i = 0; i < 4; ++i) {
      const int idx = tid + 256 * i, kr = idx >> 4, n4 = idx & 15;
      T[kr * 65 + n4 * 4 + 0] = r[i][0]; T[kr * 65 + n4 * 4 + 1] = r[i][1]; T[kr * 65 + n4 * 4 + 2] = r[i][2]; T[kr * 65 + n4 * 4 + 3] = r[i][3];
    }
    __syncthreads();
    {
      const int ntn = D.N >> 6, kt = D.tile / ntn, nt = D.tile % ntn;
#pragma unroll
      for (int i = 0; i < 2; ++i) {
        const int idx = tid + 256 * i, n = idx >> 3, kc = idx & 7;
        u32x4 o;
        o.x = pack2(T[(kc * 8 + 0) * 65 + n], T[(kc * 8 + 1) * 65 + n]);
        o.y = pack2(T[(kc * 8 + 2) * 65 + n], T[(kc * 8 + 3) * 65 + n]);
        o.z = pack2(T[(kc * 8 + 4) * 65 + n], T[(kc * 8 + 5) * 65 + n]);
        o.w = pack2(T[(kc * 8 + 6) * 65 + n], T[(kc * 8 + 7) * 65 + n]);
        const int cfull = nt * 64 + n, c32 = cfull & 31, rho = ((c32 >> 2) & 1) * 16 + (c32 >> 3) * 4 + (c32 & 3);
        *(u32x4*)(D.dst + blk_off((cfull & ~31) + rho, kt * 64 + kc * 8, D.K)) = o;
      }
    }
#pragma unroll
    for (int i = 0; i < 4; ++i) r[i] = rn[i];
    D = Dn;
    t = tn;
  }
}

__device__ void phase0b(PRef P) {
  const size_t gtid = (size_t)blockIdx.x * 256 + otid(), gsz = (size_t)gridDim.x * 256;
}

__device__ void tables_expand(PRef P) {
  const size_t gtid = (size_t)blockIdx.x * 256 + otid(), gsz = (size_t)gridDim.x * 256;
  for (size_t e8 = gtid; e8 < (size_t)2 * 16 * 512 * 96; e8 += gsz) {
    const int k0 = (int)(e8 % 96) * 8;
    const int m = (int)((e8 / 96) % 512);
    const int lg = (int)(e8 / (96 * 512));
    const int l = lg >> 4, g = lg & 15, i = m >> 4, hh = m & 15;
    const int ldg0 = (l * 2 + 0) * 16 + g, ldg1 = (l * 2 + 1) * 16 + g;
    float v[8];
    if (k0 < 512) {
      const int j = k0 >> 4, h2 = k0 & 15;
      f32x4 a0 = (f32x4){0.f, 0.f, 0.f, 0.f}, a1 = a0, b0 = a0, b1 = a0;
      if (j <= i) { const float* kp = P.ktab + (size_t)ldg0 * 8192 + (i - j) * 256 + hh * 16 + h2; a0 = *(const f32x4*)kp; a1 = *(const f32x4*)(kp + 4); }
      if (j >= i) { const float* kp = P.ktab + (size_t)ldg1 * 8192 + (j - i) * 256 + hh * 16 + h2; b0 = *(const f32x4*)kp; b1 = *(const f32x4*)(kp + 4); }
      const float dsk = P.s5_d[l * 256 + g * 16 + hh];
#pragma unroll
      for (int q = 0; q < 4; ++q) { v[q] = a0[q] + b0[q]; v[4 + q] = a1[q] + b1[q]; }
      if (j == i && hh >= h2 && hh < h2 + 8) {
#pragma unroll
        for (int q = 0; q < 8; ++q) if (q == hh - h2) v[q] += dsk;
      }
    } else {
      const int d = (k0 >= 640) ? 1 : 0;
      const int p0 = ((k0 - 512) & 127) >> 1;
      const int ldg = d ? ldg1 : ldg0;
      const int pw = d ? (32 - i) : (i + 1);
      const f32x4 cr = *(const f32x4*)(P.s5_c_re + ((size_t)ldg * 16 + hh) * 64 + p0), ci = *(const f32x4*)(P.s5_c_im + ((size_t)ldg * 16 + hh) * 64 + p0);
      float2 a[4];
#pragma unroll
      for (int q = 0; q < 4; ++q) a[q] = P.apow[((size_t)ldg * 64 + p0 + q) * 33 + pw];
#pragma unroll
      for (int q = 0; q < 4; ++q) { v[2 * q] = cr[q] * a[q].x - ci[q] * a[q].y; v[2 * q + 1] = -(cr[q] * a[q].y + ci[q] * a[q].x); }
    }
    u32x4 o; o.x = pack2(v[0], v[1]); o.y = pack2(v[2], v[3]); o.z = pack2(v[4], v[5]); o.w = pack2(v[6], v[7]);
    *(u32x4*)(P.atab + (size_t)lg * 512 * 768 + blk_off(m, k0, 768)) = o;
  }
  for (size_t e8 = gtid; e8 < (size_t)2 * 16 * 256 * 64; e8 += gsz) {
    const int k0 = (int)(e8 % 64) * 8;
    const int row = (int)((e8 / 64) % 256);
    const int lg = (int)(e8 / (64 * 256));
    const int l = lg >> 4, g = lg & 15;
    const int d = row >> 7, p = (row & 127) >> 1, ri = row & 1;
    const int ldg = (l * 2 + d) * 16 + g;
    const int j = k0 >> 4, h2 = k0 & 15;
    const int pw = d ? j : (31 - j);
    const float2 a = P.apow[((size_t)ldg * 64 + p) * 33 + pw];
    const f32x4* bp = (const f32x4*)(P.bbar + ((size_t)ldg * 64 + p) * 16 + h2);
    const f32x4 b0 = bp[0], b1 = bp[1], b2 = bp[2], b3 = bp[3];
    const float br[8] = {b0[0], b0[2], b1[0], b1[2], b2[0], b2[2], b3[0], b3[2]};
    const float bi[8] = {b0[1], b0[3], b1[1], b1[3], b2[1], b2[3], b3[1], b3[3]};
    float v[8];
#pragma unroll
    for (int q = 0; q < 8; ++q) v[q] = ri ? (a.x * bi[q] + a.y * br[q]) : (a.x * br[q] - a.y * bi[q]);
    u32x4 o; o.x = pack2(v[0], v[1]); o.y = pack2(v[2], v[3]); o.z = pack2(v[4], v[5]); o.w = pack2(v[6], v[7]);
    *(u32x4*)(P.wtab + (size_t)lg * 256 * 512 + blk_off(row, k0, 512)) = o;
  }
}

__device__ void normmod_phase(PRef P, int l, int which) {
  const int lane = otid() & 63, w = otid() >> 6;
  const float* gam = (which == 0 ? P.norm_mix : P.norm_mlp) + l * 1024;
  const bool addp = (which == 0 && l > 0);
  for (int n = blockIdx.x * 4 + w; n < NTOK; n += gridDim.x * 4) {
    float* xr = P.out + (size_t)n * 1024;
    const float* xin = (l == 0 && which == 0) ? (n < NCTX ? P.x_prompt + (size_t)n * 1024 : P.x_sample + (size_t)(n - NCTX) * 1024) : xr;
    const float* md = P.mod + ((size_t)(l * 3 + variant_of(n))) * 6144 + (which == 0 ? 0 : 3072);
    f32x4 v[4];
    float ss = 0.f;
#pragma unroll
    for (int i = 0; i < 4; ++i) {
      const int k = lane * 8 + 512 * (i >> 1) + 4 * (i & 1);
      v[i] = *(const f32x4*)(xin + k);
      if (addp) {
        v[i] = v[i] + *(const f32x4*)(P.pbuf + (size_t)n * 1024 + k);
        *(f32x4*)(xr + k) = v[i];
      }
      ss += v[i][0] * v[i][0] + v[i][1] * v[i][1] + v[i][2] * v[i][2] + v[i][3] * v[i][3];
    }
    f32x4 gq[4], shq[4], scq[4];
#pragma unroll
    for (int i = 0; i < 4; ++i) {
      const int k = lane * 8 + 512 * (i >> 1) + 4 * (i & 1);
      gq[i] = *(const f32x4*)(gam + k); shq[i] = *(const f32x4*)(md + k); scq[i] = *(const f32x4*)(md + 1024 + k);
    }
    ss = wave_sum(ss);
    const float rstd = rsqrtf(ss * (1.f / 1024.f) + 1e-6f);
#pragma unroll
    for (int j = 0; j < 2; ++j) {
      const int k = lane * 8 + 512 * j;
      const f32x4 o0 = v[2 * j] * rstd * gq[2 * j] * (1.f + scq[2 * j]) + shq[2 * j];
      const f32x4 o1 = v[2 * j + 1] * rstd * gq[2 * j + 1] * (1.f + scq[2 * j + 1]) + shq[2 * j + 1];
      u32x4 ov; ov.x = pack2(o0[0], o0[1]); ov.y = pack2(o0[2], o0[3]); ov.z = pack2(o1[0], o1[1]); ov.w = pack2(o1[2], o1[3]);
      *(u32x4*)(P.h + blk_off(n, k, 1024)) = ov;
    }
  }
  if (l == 0 && which == 0) tables_expand(P);
}

__device__ void final_phase(PRef P) {
  const int lane = otid() & 63, w = otid() >> 6;
  for (int n = blockIdx.x * 4 + w; n < NTOK; n += gridDim.x * 4) {
    float* xr = P.out + (size_t)n * 1024;
    f32x4 v[4];
    float ss = 0.f;
#pragma unroll
    for (int i = 0; i < 4; ++i) {
      v[i] = *(const f32x4*)(xr + lane * 4 + 256 * i) + *(const f32x4*)(P.pbuf + (size_t)n * 1024 + lane * 4 + 256 * i);
      ss += v[i][0] * v[i][0] + v[i][1] * v[i][1] + v[i][2] * v[i][2] + v[i][3] * v[i][3];
    }
    ss = wave_sum(ss);
    const float rstd = rsqrtf(ss * (1.f / 1024.f) + 1e-6f);
#pragma unroll
    for (int i = 0; i < 4; ++i) {
      const int k = lane * 4 + 256 * i;
      const f32x4 g = *(const f32x4*)(P.norm_final + k);
      *(f32x4*)(xr + k) = v[i] * rstd * g;
    }
  }
}

__device__ void win_phase(PRef P, int l, char* lds) {
  for (int u = blockIdx.x; u < 48 * 24; u += gridDim.x) {
    const int mt = u / 24, nt = u % 24, m0 = mt * 128, n0 = nt * 128;
    gemm_tile<4, false, true>(P.h + blk_off(m0, 0, 1024), P.wt_in + (size_t)l * 3072 * 1024 + blk_off(n0, 0, 1024), 32, lds,
      [&](int rl, int cl, f32x4 v, f32x4 w2) {
        const int n = m0 + rl, c = n0 + cl;
        u32x4 zo; zo.x = pack2(v[0], v[1]); zo.y = pack2(v[2], v[3]); zo.z = pack2(w2[0], w2[1]); zo.w = pack2(w2[2], w2[3]);
        *(u32x4*)(P.z + (size_t)n * 3072 + c) = zo;
        if (c < 256) {
          if (n < NCTX && ((n & 255) == 0 || (n & 255) == 255)) {
            float* ue = P.uedge + (size_t)((n >> 8) * 2 + ((n & 255) ? 1 : 0)) * 256 + c;
            *(f32x4*)ue = v; *(f32x4*)(ue + 4) = w2;
          }
          const int g = c >> 4;
          *(u32x4*)(P.bts5 + (size_t)g * 256 * 768 + blk_off(n >> 5, (n & 31) * 16 + (c & 15), 768)) = zo;
        }
        if (c >= 2048 && n < NCTX) {
          const int b = n >> 8, t = n & 255;
          float* dst = P.out + (c < 2560 ? OUT_CK : OUT_CV) + ((size_t)((b * 2 + l) * 256 + t)) * 512 + ((c - 2048) & 511);
          *(f32x4*)dst = v; *(f32x4*)(dst + 4) = w2;
        }
      });
  }
}

template <bool DUMMY = false>
__device__ void wout_phase(PRef P, int l, char* lds) {
  for (int u = blockIdx.x; u < 48 * 16; u += gridDim.x) {
    const int mt = u / 16, nt = u % 16, m0 = mt * 128, n0 = nt * 64;
    gemm_tile<2, false, true>(P.mix + blk_off(m0, 0, 1024), P.wt_out + (size_t)l * 1024 * 1024 + blk_off(n0, 0, 1024), 32, lds,
      [&](int rl, int cl, f32x4 v, f32x4 w2) {
        const int n = m0 + rl, c = n0 + cl;
        const float* gp = P.mod + ((size_t)(l * 3 + variant_of(n))) * 6144 + 2048 + c;
        f32x4* xp = (f32x4*)((DUMMY ? P.kv : P.out) + (size_t)n * 1024 + c);
        const f32x4* xs = (l == 0) ? (const f32x4*)((n < NCTX ? P.x_prompt + (size_t)n * 1024 : P.x_sample + (size_t)(n - NCTX) * 1024) + c) : xp;
        const f32x4 x0 = xs[0], x1 = xs[1];
        xp[0] = x0 + *(const f32x4*)gp * v; xp[1] = x1 + *(const f32x4*)(gp + 4) * w2;
      });
  }
}

__device__ void mlp1_phase(PRef P, int l, char* lds) {
  for (int u = blockIdx.x; u < 48 * 32; u += gridDim.x) {
    const int mt = u / 32, nt = u % 32, m0 = mt * 128, n0 = nt * 128;
    gemm_tile<4, false, true>(P.h + blk_off(m0, 0, 1024), P.wt_m1 + (size_t)l * 4096 * 1024 + blk_off(n0, 0, 1024), 32, lds,
      [&](int rl, int cl, f32x4 v, f32x4 w2) {
        const int n = m0 + rl, c = n0 + cl;
        const f32x4 z4 = (f32x4){0.f, 0.f, 0.f, 0.f};
        const f32x4 a = __builtin_elementwise_max(v, z4), b = __builtin_elementwise_max(w2, z4);
        const f32x4 aa = a * a, bb = b * b;
        u32x4 o; o.x = pack2(aa[0], aa[1]); o.y = pack2(aa[2], aa[3]); o.z = pack2(bb[0], bb[1]); o.w = pack2(bb[2], bb[3]);
        *(u32x4*)(P.hid + blk_off(n, c, 4096)) = o;
      });
  }
}

template <bool HOT>
__device__ void mlp1_dummy_phase(PRef P, int l, char* lds) {
  for (int u = blockIdx.x; u < 48 * 32; u += gridDim.x) {
    const int mt = u / 32, nt = u % 32, m0 = mt * 128, n0 = nt * 128;
    gemm_tile<4, HOT>(P.h + blk_off(m0, 0, 1024), P.wt_m1 + (size_t)l * 4096 * 1024 + blk_off(n0, 0, 1024), 32, lds,
      [&](int rl, int cl, f32x4 v) {
        if (v[0] == 12345.678f) P.kv[rl * 128 + cl] = v[1];
      });
  }
}

template <bool DUMMY = false>
__device__ void mlp2_phase(PRef P, int l, char* lds) {
  for (int u = blockIdx.x; u < 48 * 8 * 2; u += gridDim.x) {
    const int ks = u & 1, t = u >> 1, mt = t / 8, nt = t % 8, m0 = mt * 128, n0 = nt * 128;
    gemm_tile<4, false, true>(P.hid + blk_off(m0, ks * 2048, 4096), P.wt_m2 + (size_t)l * 1024 * 4096 + blk_off(n0, ks * 2048, 4096), 64, lds,
      [&](int rl, int cl, f32x4 v, f32x4 w2) {
        const int n = m0 + rl, c = n0 + cl;
        const float* gp = P.mod + ((size_t)(l * 3 + variant_of(n))) * 6144 + 5120 + c;
        const f32x4 g0 = *(const f32x4*)gp, g1 = *(const f32x4*)(gp + 4);
        if (ks == 0) {
          f32x4* xp = (f32x4*)((DUMMY ? P.kv : P.out) + (size_t)n * 1024 + c);
          const f32x4 x0 = xp[0], x1 = xp[1];
          xp[0] = x0 + g0 * v; xp[1] = x1 + g1 * w2;
        } else {
          f32x4* pp = (f32x4*)((DUMMY ? P.kv : P.pbuf) + (size_t)n * 1024 + c);
          pp[0] = g0 * v; pp[1] = g1 * w2;
        }
      });
  }
}

__device__ void s5e_unit(PRef P, int l, int u, char* lds) {
  const int g = u >> 2, mt = (u >> 1) & 1, nt = u & 1;
  gemm_tile(P.bts5 + (size_t)g * 256 * 768 + blk_off(nt * 128, 0, 768), P.wtab + (size_t)(l * 16 + g) * 256 * 512 + blk_off(mt * 128, 0, 512), 16, lds,
    [&](int rl, int cl, f32x4 v) {
      const int col = nt * 128 + rl, m = mt * 128 + cl;
      if (col < 192) *(f32x4*)(P.E + ((size_t)(g * 192 + col)) * 256 + m) = v;
    });
}

__device__ void s5y_unit(PRef P, int l, int u, char* lds) {
  const int g = u >> 4, mt = (u >> 1) & 7, nt = u & 1;
  gemm_tile<2>(P.bts5 + (size_t)g * 256 * 768 + blk_off(nt * 128, 0, 768), P.atab + (size_t)(l * 16 + g) * 512 * 768 + blk_off(mt * 64, 0, 768), 24, lds,
    [&](int rl, int cl, f32x4 v) {
      const int col = nt * 128 + rl, m = mt * 64 + cl;
      if (col < 192) {
        const int i = m >> 4, hh = m & 15, n = col * 32 + i;
        uint2 o; o.x = pack2(gelu_tanh(v[0]), gelu_tanh(v[1])); o.y = pack2(gelu_tanh(v[2]), gelu_tanh(v[3]));
        *(uint2*)(P.xg + blk_off(n, g * 16 + hh, 256)) = o;
      }
    });
}

__device__ void glu_unit(PRef P, int l, int u, char* lds) {
  {
    const int mt = u >> 1, nt = u & 1, m0 = mt * 128, n0 = nt * 128;
    gemm_tile<4, false, true>(P.xg + blk_off(m0, 0, 256), P.wt_glu + (size_t)l * 256 * 256 + blk_off(n0, 0, 256), 8, lds,
      [&](int rl, int cl, f32x4 v, f32x4 w2) {
        const int n = m0 + rl, c = n0 + cl;
        const u32x4 xv = *(const u32x4*)(P.xg + blk_off(n, c, 256));
        const float* bp = P.s5_b_glu + l * 256 + c;
        const f32x4 b0 = *(const f32x4*)bp, b1 = *(const f32x4*)(bp + 4);
        u32x4 o;
        o.x = pack2(bf2f((bf16_t)(xv.x & 0xffff)) * sigmoid_(v[0] + b0[0]), bf2f((bf16_t)(xv.x >> 16)) * sigmoid_(v[1] + b0[1]));
        o.y = pack2(bf2f((bf16_t)(xv.y & 0xffff)) * sigmoid_(v[2] + b0[2]), bf2f((bf16_t)(xv.y >> 16)) * sigmoid_(v[3] + b0[3]));
        o.z = pack2(bf2f((bf16_t)(xv.z & 0xffff)) * sigmoid_(w2[0] + b1[0]), bf2f((bf16_t)(xv.z >> 16)) * sigmoid_(w2[1] + b1[1]));
        o.w = pack2(bf2f((bf16_t)(xv.w & 0xffff)) * sigmoid_(w2[2] + b1[2]), bf2f((bf16_t)(xv.w >> 16)) * sigmoid_(w2[3] + b1[3]));
        *(u32x4*)(P.mix + blk_off(n, c, 1024)) = o;
      });
  }
}

__device__ void attn_unit(PRef P, int l, int unit, char* lds) {
  char* Ks = lds;
  bf16_t* Vt = (bf16_t*)(lds + 8192);
  float* rpbS = (float*)(lds + 8192 + 64 * 68 * 2);
  const int tid = otid(), lane = tid & 63, w = tid >> 6, fr = lane & 15, fq = lane >> 4;
  const bool lat = unit < 256;
  int b, h, qrow0, ntiles, r = 0, r_start = 0;
  if (lat) { b = unit >> 7; h = (unit >> 4) & 7; r = unit & 15; qrow0 = NCTX + b * 1024 + r * 64; ntiles = 16; r_start = min(max(r - 4, 0), 8); }
  else { const int v = unit - 256; b = v >> 5; h = (v >> 2) & 7; qrow0 = b * 256 + (v & 3) * 64; ntiles = 4; }
  __syncthreads();
  if (lat) for (int i = tid; i < 465; i += 256) rpbS[i] = P.na_rpb[(size_t)((l * 8 + h) * 15) * 31 + i];
  bf16x8 qf[2];
  {
    const bf16_t* zq = P.z + (size_t)(qrow0 + w * 16 + fr) * 3072 + 1536 + h * 64;
#pragma unroll
    for (int ks = 0; ks < 2; ++ks) {
      const bf16x8 a = *(const bf16x8*)(zq + ks * 32 + fq * 8);
#pragma unroll
      for (int j = 0; j < 8; ++j) qf[ks][j] = (short)f2bf(bf2f((bf16_t)a[j]) * 0.125f);
    }
  }
  const int bandw = __builtin_amdgcn_readfirstlane(min(max(w * 16 - 8, 0), 32));
  float m = -INFINITY, lsum = 0.f;
  f32x4 o[4];
#pragma unroll
  for (int i = 0; i < 4; ++i) o[i] = (f32x4){0.f, 0.f, 0.f, 0.f};
  u32x4 kr[2], vr[2];
#define ATT_LOAD_TILE(t_)                                                                                              \
  {                                                                                                                    \
    const int tt = (t_);                                                                                               \
    const bf16_t* kp; const bf16_t* vp; int ld;                                                                        \
    if (lat && tt < 8) {                            \
      const size_t base = ((size_t)((b * 2 + l) * 512 + tt * 64)) * 512 + h * 64;                                      \
      kp = P.ckb + base; vp = P.cvb + base; ld = 512;                                                                  \
    } else {                                                            \
      const int row0 = lat ? (NCTX + b * 1024 + (r_start + tt - 8) * 64) : (b * 256 + tt * 64);                        \
      kp = P.z + (size_t)row0 * 3072 + 2048 + h * 64; vp = kp + 512; ld = 3072;                                        \
    }                                                                                                                  \
    _Pragma("unroll") for (int i = 0; i < 2; ++i) {                                                                    \
      const int c = tid + 256 * i, key = c >> 3, ch = c & 7;                                                           \
      kr[i] = *(const u32x4*)(kp + (size_t)key * ld + ch * 8);                                                         \
      vr[i] = *(const u32x4*)(vp + (size_t)key * ld + ch * 8);                                                         \
    }                                                                                                                  \
  }
  ATT_LOAD_TILE(0);
  for (int t = 0; t < ntiles; ++t) {
    __syncthreads();
#pragma unroll
    for (int i = 0; i < 2; ++i) {
      const int c = tid + 256 * i, key = c >> 3, ch = c & 7;
      *(u32x4*)(Ks + key * 128 + ((ch ^ ((key >> 1) & 7)) << 4)) = kr[i];
      const u32x4 vb = vr[i];
#pragma unroll
      for (int e = 0; e < 4; ++e) {
        Vt[(ch * 8 + 2 * e) * 68 + key] = (bf16_t)(vb[e] & 0xffffu);
        Vt[(ch * 8 + 2 * e + 1) * 68 + key] = (bf16_t)(vb[e] >> 16);
      }
    }
    __syncthreads();
    if (t + 1 < ntiles) ATT_LOAD_TILE(t + 1);
    __builtin_amdgcn_sched_barrier(0);
    const bool win = lat && t >= 8;
    const int band = win ? bandw : 0;
    const int nkt = win ? 2 : 4;
    f32x4 s[4];
#pragma unroll
    for (int kt = 0; kt < 4; ++kt) {
      if (kt < nkt) {
        s[kt] = (f32x4){0.f, 0.f, 0.f, 0.f};
        const int key = band + kt * 16 + fr;
#pragma unroll
        for (int ks = 0; ks < 2; ++ks) {
          const bf16x8 a = *(const bf16x8*)(Ks + key * 128 + (((ks * 4 + fq) ^ ((key >> 1) & 7)) << 4));
          s[kt] = __builtin_amdgcn_mfma_f32_16x16x32_bf16(a, qf[ks], s[kt], 0, 0, 0);
        }
      } else {
        s[kt] = (f32x4){-1e30f, -1e30f, -1e30f, -1e30f};
      }
    }
    if (win) {
      const int dr = r_start + (t - 8) - r + 7;
      const int qc = w * 16 + fr;
      const int cs = min(max(qc - 8, 0), 48);
#pragma unroll
      for (int kt = 0; kt < 2; ++kt)
#pragma unroll
        for (int rr = 0; rr < 4; ++rr) {
          const int kc = band + kt * 16 + fq * 4 + rr;
          const bool in = (kc >= cs) && (kc < cs + 16);
          const int dc = min(max(kc - qc + 15, 0), 30);
          s[kt][rr] = in ? s[kt][rr] + rpbS[dr * 31 + dc] : -1e30f;
        }
    }
    float mx = -INFINITY;
#pragma unroll
    for (int kt = 0; kt < 4; ++kt)
#pragma unroll
      for (int rr = 0; rr < 4; ++rr) mx = fmaxf(mx, s[kt][rr]);
    mx = fmaxf(mx, __shfl_xor(mx, 16));
    mx = fmaxf(mx, __shfl_xor(mx, 32));
    const float mn = fmaxf(m, mx);
    const float alpha = __expf(m - mn);
    float ps = 0.f;
#pragma unroll
    for (int kt = 0; kt < 4; ++kt)
#pragma unroll
      for (int rr = 0; rr < 4; ++rr) { s[kt][rr] = __expf(s[kt][rr] - mn); ps += s[kt][rr]; }
    ps += __shfl_xor(ps, 16);
    ps += __shfl_xor(ps, 32);
    lsum = lsum * alpha + ps;
    m = mn;
#pragma unroll
    for (int i = 0; i < 4; ++i) o[i] = o[i] * alpha;
#pragma unroll
    for (int c = 0; c < 2; ++c) {
      if (2 * c >= nkt) continue;
      bf16x8 pb;
      pb[0] = (short)f2bf(s[2 * c][0]); pb[1] = (short)f2bf(s[2 * c][1]); pb[2] = (short)f2bf(s[2 * c][2]); pb[3] = (short)f2bf(s[2 * c][3]);
      pb[4] = (short)f2bf(s[2 * c + 1][0]); pb[5] = (short)f2bf(s[2 * c + 1][1]); pb[6] = (short)f2bf(s[2 * c + 1][2]); pb[7] = (short)f2bf(s[2 * c + 1][3]);
#pragma unroll
      for (int dt = 0; dt < 4; ++dt) {
        const int d = dt * 16 + fr;
        const u32x2 lo = *(const u32x2*)(Vt + d * 68 + band + (2 * c) * 16 + fq * 4);
        const u32x2 hi = *(const u32x2*)(Vt + d * 68 + band + (2 * c + 1) * 16 + fq * 4);
        const u32x4 avu = (u32x4){lo.x, lo.y, hi.x, hi.y};
        o[dt] = __builtin_amdgcn_mfma_f32_16x16x32_bf16(__builtin_bit_cast(bf16x8, avu), pb, o[dt], 0, 0, 0);
      }
    }
  }
  const float inv = 1.f / lsum;
#pragma unroll
  for (int dt = 0; dt < 4; ++dt) {
    uint2 ov; ov.x = pack2(o[dt][0] * inv, o[dt][1] * inv); ov.y = pack2(o[dt][2] * inv, o[dt][3] * inv);
    *(uint2*)(P.mix + blk_off(qrow0 + w * 16 + fr, 512 + h * 64 + dt * 16 + fq * 4, 1024)) = ov;
  }
}

__device__ void hgrn_a_unit(PRef P, int l, int unit, char* lds) {
  float* fS = (float*)lds;
  float* vS = fS + 4096;
  const int tid = otid(), dv = tid & 63, q4 = tid >> 6;
  const int mc = unit >> 3, h = (unit >> 1) & 3, d = unit & 1, n0 = mc * 64;
  const int zfcol = (d == 0 ? 512 : 768) + h * 64;
  __syncthreads();
#pragma unroll 4
  for (int e = 0; e < 16; ++e) {
    const int idx = tid + 256 * e, s = idx >> 6, ch = idx & 63;
    const bf16_t* zrow = P.z + (size_t)(n0 + s) * 3072;
    const float lb = lbv(P, l, h * 64 + ch);
    fS[idx] = lb + (1.f - lb) * sigmoid_(bf2f(zrow[zfcol + ch]));
    vS[idx] = bf2f(zrow[1024 + h * 64 + ch]);
  }
  __syncthreads();
  f32x2 S[8];
#pragma unroll
  for (int j = 0; j < 8; ++j) S[j] = (f32x2){0.f, 0.f};
  for (int i = 0; i < 64; ++i) {
    const int s = d ? 63 - i : i;
    const float vv = vS[s * 64 + dv];
    const f32x2 vv2 = (f32x2){vv, vv};
#pragma unroll
    for (int j = 0; j < 8; ++j) {
      const f32x2 fv = *(const f32x2*)(fS + s * 64 + q4 * 16 + 2 * j);
      S[j] = fv * (S[j] - vv2) + vv2;
    }
  }
#pragma unroll
  for (int j = 0; j < 8; ++j) {
    P.kv[((size_t)unit * 64 + q4 * 16 + 2 * j) * 64 + dv] = S[j][0];
    P.kv[((size_t)unit * 64 + q4 * 16 + 2 * j + 1) * 64 + dv] = S[j][1];
  }
  if (tid < 64) {
    float g = 1.f;
    for (int s = 0; s < 64; ++s) g *= fS[s * 64 + tid];
    P.gdec[unit * 64 + tid] = g;
  }
}

__device__ void hgrn_b_unit(PRef P, int l, int unit, char* lds) {
  float* fS = (float*)lds;
  float* qS = fS + 1024;
  float* vS = qS + 1024;
  float* opart = vS + 1024;
  const int tid = otid(), dv = tid & 63, q4 = tid >> 6;
  const int mc = unit >> 3, h = (unit >> 1) & 3, d = unit & 1, n0 = mc * 64;
  f32x2 S[8];
#pragma unroll
  for (int j = 0; j < 8; ++j) {
    S[j][0] = P.sst[((size_t)unit * 64 + q4 * 16 + 2 * j) * 64 + dv];
    S[j][1] = P.sst[((size_t)unit * 64 + q4 * 16 + 2 * j + 1) * 64 + dv];
  }
  const int zfcol = (d == 0 ? 512 : 768) + h * 64;
  float rf[4], rq[4], rv[4], rlb[4];
#pragma unroll
  for (int e = 0; e < 4; ++e) rlb[e] = lbv(P, l, h * 64 + ((tid + 256 * e) & 63));
#define HG_LOAD(sub_)                                                                              \
  _Pragma("unroll") for (int e = 0; e < 4; ++e) {                                                  \
    const int idx = tid + 256 * e, i = idx >> 6, ch = idx & 63, tl = (sub_) * 16 + i, s = d ? 63 - tl : tl; \
    const bf16_t* zrow = P.z + (size_t)(n0 + s) * 3072;                                           \
    rf[e] = bf2f(zrow[zfcol + ch]); rq[e] = bf2f(zrow[256 + h * 64 + ch]); rv[e] = bf2f(zrow[1024 + h * 64 + ch]);  \
  }
  HG_LOAD(0);
  for (int sub = 0; sub < 4; ++sub) {
    __syncthreads();
#pragma unroll
    for (int e = 0; e < 4; ++e) {
      const int idx = tid + 256 * e;
      fS[idx] = rlb[e] + (1.f - rlb[e]) * sigmoid_(rf[e]);
      qS[idx] = silu_(rq[e]);
      vS[idx] = rv[e];
    }
    __syncthreads();
    if (sub + 1 < 4) HG_LOAD(sub + 1);
    __builtin_amdgcn_sched_barrier(0);
    for (int i = 0; i < 16; ++i) {
      f32x2 po = (f32x2){0.f, 0.f};
      const float vv = vS[i * 64 + dv];
      const f32x2 vv2 = (f32x2){vv, vv};
#pragma unroll
      for (int j = 0; j < 8; ++j) {
        const f32x2 fv = *(const f32x2*)(fS + i * 64 + q4 * 16 + 2 * j);
        const f32x2 qv = *(const f32x2*)(qS + i * 64 + q4 * 16 + 2 * j);
        S[j] = fv * (S[j] - vv2) + vv2;
        po = S[j] * qv + po;
      }
      opart[(q4 * 16 + i) * 64 + dv] = po[0] + po[1];
    }
    __syncthreads();
#pragma unroll
    for (int e = 0; e < 4; ++e) {
      const int idx = tid + 256 * e, i = idx >> 6, dvv = idx & 63, tl = sub * 16 + i, s = d ? 63 - tl : tl;
      const float sum = opart[(0 * 16 + i) * 64 + dvv] + opart[(1 * 16 + i) * 64 + dvv] + opart[(2 * 16 + i) * 64 + dvv] + opart[(3 * 16 + i) * 64 + dvv];
      P.obuf[((size_t)d * NTOK + n0 + s) * 256 + h * 64 + dvv] = sum;
    }
  }
}

template <bool OUT>
__device__ void hgrn_mfma_unit(PRef P, int l, int su, char* lds) {
  const int tid = otid(), lane = tid & 63, w = tid >> 6, fr = lane & 15, fq = lane >> 4;
  const int mc = su >> 3, h = (su >> 1) & 3, d = su & 1, n0 = mc * 64;
  const int zfcol = (d == 0 ? 512 : 768) + h * 64;
  const int tn = w;
  f32x4 S[4];
#pragma unroll
  for (int tm = 0; tm < 4; ++tm)
#pragma unroll
    for (int r = 0; r < 4; ++r) S[tm][r] = OUT ? P.sst[((size_t)su * 64 + tm * 16 + fq * 4 + r) * 64 + tn * 16 + fr] : 0.f;
  __syncthreads();
  {
    const int sub = w;
    char* wl = lds + sub * 10752;
    bf16_t* qa = (bf16_t*)wl;
    bf16_t* qs = qa + 1024;
    bf16_t* ka = qs + 1024;
    bf16_t* kT = ka + 1024;
    bf16_t* vT = kT + 1024;
    float* gS = (float*)(vT + 1024);
    const float lb = lbv(P, l, h * 64 + lane);
    float bc[16], kk[16], vv[16], qq[16];
#pragma unroll
    for (int i = 0; i < 16; ++i) {
      const int tl = sub * 16 + i, st = d ? 63 - tl : tl;
      const bf16_t* zrow = P.z + (size_t)(n0 + st) * 3072;
      kk[i] = bf2f(zrow[zfcol + lane]);
      vv[i] = bf2f(zrow[1024 + h * 64 + lane]);
      if (OUT) qq[i] = bf2f(zrow[256 + h * 64 + lane]);
    }
    {
      float run = 0.f;
#pragma unroll
      for (int i = 0; i < 16; ++i) {
        const float f = lb + (1.f - lb) * sigmoid_(kk[i]);
        run += __logf(f);
        bc[i] = run;
        kk[i] = 1.f - f;
      }
    }
    const float bmid = bc[7], bend = bc[15];
    gS[lane] = __expf(bend);
    {
      u32x4 p0, p1;
      p0.x = pack2(kk[0] * __expf(bend - bc[0]), kk[1] * __expf(bend - bc[1]));
      p0.y = pack2(kk[2] * __expf(bend - bc[2]), kk[3] * __expf(bend - bc[3]));
      p0.z = pack2(kk[4] * __expf(bend - bc[4]), kk[5] * __expf(bend - bc[5]));
      p0.w = pack2(kk[6] * __expf(bend - bc[6]), kk[7] * __expf(bend - bc[7]));
      p1.x = pack2(kk[8] * __expf(bend - bc[8]), kk[9] * __expf(bend - bc[9]));
      p1.y = pack2(kk[10] * __expf(bend - bc[10]), kk[11] * __expf(bend - bc[11]));
      p1.z = pack2(kk[12] * __expf(bend - bc[12]), kk[13] * __expf(bend - bc[13]));
      p1.w = pack2(kk[14] * __expf(bend - bc[14]), kk[15]);
      *(u32x4*)(kT + lane * 16) = p0;
      *(u32x4*)(kT + lane * 16 + 8) = p1;
      p0.x = pack2(vv[0], vv[1]); p0.y = pack2(vv[2], vv[3]); p0.z = pack2(vv[4], vv[5]); p0.w = pack2(vv[6], vv[7]);
      p1.x = pack2(vv[8], vv[9]); p1.y = pack2(vv[10], vv[11]); p1.z = pack2(vv[12], vv[13]); p1.w = pack2(vv[14], vv[15]);
      *(u32x4*)(vT + lane * 16) = p0;
      *(u32x4*)(vT + lane * 16 + 8) = p1;
    }
    if (OUT) {
#pragma unroll
      for (int i = 0; i < 16; ++i) {
        ka[i * 64 + lane] = f2bf(kk[i] * __expf(fminf(bmid - bc[i], 80.f)));
        const float q = silu_(qq[i]);
        qa[i * 64 + lane] = f2bf(q * __expf(fminf(bc[i] - bmid, 80.f)));
        qs[i * 64 + lane] = f2bf(q * __expf(bc[i]));
      }
    }
  }
  __syncthreads();
  for (int sub = 0; sub < 4; ++sub) {
    const char* wl = lds + sub * 10752;
    const bf16_t* qa = (const bf16_t*)wl;
    const bf16_t* qs = qa + 1024;
    const bf16_t* ka = qs + 1024;
    const bf16_t* kT = ka + 1024;
    const bf16_t* vT = kT + 1024;
    const float* gS = (const float*)(vT + 1024);
    const u32x2 t2 = *(const u32x2*)(vT + (tn * 16 + fr) * 16 + fq * 4);
    const bf16x8 vb = __builtin_bit_cast(bf16x8, (u32x4){t2.x, t2.y, 0u, 0u});
    if (OUT) {
      f32x4 at = (f32x4){0.f, 0.f, 0.f, 0.f};
#pragma unroll
      for (int ks = 0; ks < 2; ++ks) {
        const bf16x8 a = *(const bf16x8*)(ka + fr * 64 + ks * 32 + fq * 8);
        const bf16x8 b = *(const bf16x8*)(qa + fr * 64 + ks * 32 + fq * 8);
        at = __builtin_amdgcn_mfma_f32_16x16x32_bf16(a, b, at, 0, 0, 0);
      }
#pragma unroll
      for (int r = 0; r < 4; ++r) if (fq * 4 + r > fr) at[r] = 0.f;
      const bf16x8 pa = __builtin_bit_cast(bf16x8, (u32x4){pack2(at[0], at[1]), pack2(at[2], at[3]), 0u, 0u});
      f32x4 o = (f32x4){0.f, 0.f, 0.f, 0.f};
      o = __builtin_amdgcn_mfma_f32_16x16x32_bf16(pa, vb, o, 0, 0, 0);
#pragma unroll
      for (int c = 0; c < 2; ++c) {
        const u32x2 lo = *(const u32x2*)(qs + fr * 64 + (2 * c) * 16 + fq * 4);
        const u32x2 hi = *(const u32x2*)(qs + fr * 64 + (2 * c + 1) * 16 + fq * 4);
        const bf16x8 qsf = __builtin_bit_cast(bf16x8, (u32x4){lo.x, lo.y, hi.x, hi.y});
        const bf16x8 sb = __builtin_bit_cast(bf16x8, (u32x4){pack2(S[2 * c][0], S[2 * c][1]), pack2(S[2 * c][2], S[2 * c][3]),
                                                               pack2(S[2 * c + 1][0], S[2 * c + 1][1]), pack2(S[2 * c + 1][2], S[2 * c + 1][3])});
        o = __builtin_amdgcn_mfma_f32_16x16x32_bf16(qsf, sb, o, 0, 0, 0);
      }
#pragma unroll
      for (int r = 0; r < 4; ++r) {
        const int tl = sub * 16 + fq * 4 + r, st = d ? 63 - tl : tl;
        P.obuf[((size_t)d * NTOK + n0 + st) * 256 + h * 64 + tn * 16 + fr] = o[r];
      }
    }
#pragma unroll
    for (int tm = 0; tm < 4; ++tm) {
      const f32x4 g4 = *(const f32x4*)(gS + tm * 16 + fq * 4);
      const u32x2 k2 = *(const u32x2*)(kT + (tm * 16 + fr) * 16 + fq * 4);
      const bf16x8 kf = __builtin_bit_cast(bf16x8, (u32x4){k2.x, k2.y, 0u, 0u});
      S[tm] = __builtin_amdgcn_mfma_f32_16x16x32_bf16(kf, vb, S[tm] * g4, 0, 0, 0);
    }
  }
  if (!OUT) {
#pragma unroll
    for (int tm = 0; tm < 4; ++tm)
#pragma unroll
      for (int r = 0; r < 4; ++r) P.kv[((size_t)su * 64 + tm * 16 + fq * 4 + r) * 64 + tn * 16 + fr] = S[tm][r];
    if (w == 0) {
      const float g = ((const float*)(lds + 0 * 10752 + 10240))[lane] * ((const float*)(lds + 1 * 10752 + 10240))[lane] *
                      ((const float*)(lds + 2 * 10752 + 10240))[lane] * ((const float*)(lds + 3 * 10752 + 10240))[lane];
      P.gdec[su * 64 + lane] = g;
    }
  }
}

__device__ void hgrn_c_all(PRef P, int l) {
  const int tid = otid(), w = tid >> 6, lane = tid & 63, sub = lane >> 4, d4 = (lane & 15) * 4;
  const f32x4 gn = *(const f32x4*)(P.hg_norm + l * 64 + d4);
  const int stride = gridDim.x * 16;
  for (int p0 = (blockIdx.x * 4 + w) * 4 + sub; p0 < NTOK * 4; p0 += stride * 4) {
    f32x4 val[4]; u32x2 gb[4];
#pragma unroll
    for (int q = 0; q < 4; ++q) {
      const int pi = p0 + q * stride;
      if (pi < NTOK * 4) {
        const int n = pi >> 2, h = pi & 3;
        val[q] = *(const f32x4*)(P.obuf + (size_t)n * 256 + h * 64 + d4) + *(const f32x4*)(P.obuf + ((size_t)NTOK + n) * 256 + h * 64 + d4);
        gb[q] = *(const u32x2*)(P.z + (size_t)n * 3072 + 1280 + h * 64 + d4);
      } else { val[q] = (f32x4){0.f, 0.f, 0.f, 0.f}; gb[q] = (u32x2){0u, 0u}; }
    }
#pragma unroll
    for (int q = 0; q < 4; ++q) {
      const int pi = p0 + q * stride;
      float ss = val[q][0] * val[q][0] + val[q][1] * val[q][1] + val[q][2] * val[q][2] + val[q][3] * val[q][3];
      ss += __shfl_xor(ss, 1); ss += __shfl_xor(ss, 2); ss += __shfl_xor(ss, 4); ss += __shfl_xor(ss, 8);
      if (pi < NTOK * 4) {
        const int n = pi >> 2, h = pi & 3;
        const float rs = rsqrtf(ss * (1.f / 64.f) + 1e-6f);
        const float g0 = bf2f((bf16_t)(gb[q].x & 0xffff)), g1 = bf2f((bf16_t)(gb[q].x >> 16)), g2 = bf2f((bf16_t)(gb[q].y & 0xffff)), g3 = bf2f((bf16_t)(gb[q].y >> 16));
        uint2 o;
        o.x = pack2(val[q][0] * rs * gn[0] * silu_(g0), val[q][1] * rs * gn[1] * silu_(g1));
        o.y = pack2(val[q][2] * rs * gn[2] * silu_(g2), val[q][3] * rs * gn[3] * silu_(g3));
        *(uint2*)(P.mix + blk_off(n, 256 + h * 64 + d4, 1024)) = o;
      }
    }
  }
}

__device__ void carry_phase(PRef P, int l) {
  const size_t gtid = (size_t)blockIdx.x * 256 + otid(), gsz = (size_t)gridDim.x * 256;
  for (size_t e = gtid; e < (size_t)18 * 4 * 2 * 4096; e += gsz) {
    const int dv = (int)(e & 63), dk = (int)((e >> 6) & 63), d = (int)((e >> 12) & 1), h = (int)((e >> 13) & 3), bb = (int)(e >> 15);
    int mcb, nc; float S;
    if (bb < 16) { mcb = bb * 4; nc = 4; S = 0.f; }
    else { mcb = 64 + (bb - 16) * 16; nc = 16; S = P.state_hgrn[((((size_t)((bb - 16) * 2 + l) * 2 + d) * 4 + h) * 64 + dk) * 64 + dv]; }
    for (int c0 = 0; c0 < nc; c0 += 4) {
      float gq[4], kq[4];
#pragma unroll
      for (int q = 0; q < 4; ++q) {
        const int cc = c0 + q, c = d ? nc - 1 - cc : cc;
        const size_t u = (size_t)((mcb + c) * 4 + h) * 2 + d;
        gq[q] = P.gdec[u * 64 + dk]; kq[q] = P.kv[(u * 64 + dk) * 64 + dv];
      }
#pragma unroll
      for (int q = 0; q < 4; ++q) {
        const int cc = c0 + q, c = d ? nc - 1 - cc : cc;
        const size_t u = (size_t)((mcb + c) * 4 + h) * 2 + d;
        P.sst[(u * 64 + dk) * 64 + dv] = S;
        S = gq[q] * S + kq[q];
      }
    }
    if (bb < 16) P.out[OUT_HG + ((((size_t)(bb * 2 + l) * 2 + d) * 4 + h) * 64 + dk) * 64 + dv] = S;
  }
  for (size_t e = gtid; e < (size_t)18 * 16 * 2 * 64; e += gsz) {
    const int p = (int)(e & 63), d = (int)((e >> 6) & 1), g = (int)((e >> 7) & 15), bb = (int)(e >> 11);
    const int ldg = (l * 2 + d) * 16 + g;
    int cb, nc; float sr, si;
    if (bb < 16) { cb = bb * 8; nc = 8; sr = 0.f; si = 0.f; }
    else {
      cb = 128 + (bb - 16) * 32; nc = 32;
      const float* sp = P.state_s5 + (((((size_t)((bb - 16) * 2 + l) * 2 + d) * 16 + g) * 64 + p) * 2);
      sr = sp[0]; si = sp[1];
    }
    const float2 aT = P.apow[((size_t)ldg * 64 + p) * 33 + 32];
    for (int c0 = 0; c0 < nc; c0 += 8) {
      f32x2 eq[8];
#pragma unroll
      for (int q = 0; q < 8; ++q) {
        const int cc = c0 + q, c = d ? nc - 1 - cc : cc;
        eq[q] = *(const f32x2*)(P.E + ((size_t)(g * 192 + cb + c)) * 256 + d * 128 + p * 2);
      }
#pragma unroll
      for (int q = 0; q < 8; ++q) {
        const int cc = c0 + q, c = d ? nc - 1 - cc : cc;
        *(unsigned*)(P.bts5 + (size_t)g * 256 * 768 + blk_off(cb + c, 512 + d * 128 + p * 2, 768)) = pack2(sr, si);
        const float nr = aT.x * sr - aT.y * si + eq[q][0], ni = aT.x * si + aT.y * sr + eq[q][1];
        sr = nr; si = ni;
      }
    }
    if (bb < 16) {
      const float* ur = P.uedge + (size_t)(bb * 2 + d) * 256 + g * 16;
      float fr_ = 0.f, fi_ = 0.f;
#pragma unroll
      for (int hh = 0; hh < 16; ++hh) {
        const float2 bv = P.bbar[((size_t)ldg * 64 + p) * 16 + hh];
        fr_ += ur[hh] * bv.x; fi_ += ur[hh] * bv.y;
      }
      float* op = P.out + OUT_S5 + (((((size_t)(bb * 2 + l) * 2 + d) * 16 + g) * 64 + p) * 2);
      op[0] = fr_; op[1] = fi_;
    }
  }
}

__device__ __forceinline__ int snake_unit(int pass, int G) { return pass * G + ((pass & 1) ? (G - 1 - (int)blockIdx.x) : (int)blockIdx.x); }
__device__ void mixa_phase(PRef P, int l, char* lds) {
  const int G = gridDim.x, bid = blockIdx.x;
  for (int pass = 0; pass < 3 || (G != 768 && pass * G < 1600); ++pass) {
    int u;
    if (G == 768) {
      if (bid < 256) u = (pass == 0) ? bid : -1;
      else {
        const int j = bid - 256;
        if (pass == 0) u = 1024 + j;
        else if (pass == 1) u = 256 + j;
        else u = (j < 256) ? 256 + 512 + j : (j < 320 ? 1536 + (j - 256) : -1);
      }
    } else {
      u = pass * G + bid;
      if (u >= 1600) u = -1;
    }
    if (u < 0) continue;
    if (u < 256 || (u >= 1024 && u < 1536)) attn_unit(P, l, u < 256 ? u : u - 768, lds);
    else if (u < 1024) hgrn_mfma_unit<false>(P, l, u - 256, lds);
    else s5e_unit(P, l, u - 1536, lds);
  }
}
__device__ void mixb_phase(PRef P, int l, char* lds) {
  for (int u = blockIdx.x; u < 768 + 256; u += gridDim.x) {
    if (u < 768) hgrn_mfma_unit<true>(P, l, u, lds);
    else s5y_unit(P, l, u - 768, lds);
  }
}
__device__ void gluc_phase(PRef P, int l, char* lds) {
  for (int u = blockIdx.x; u < 96; u += gridDim.x) glu_unit(P, l, u, lds);
  hgrn_c_all(P, l);
}

#define XB_TMO      128
#define XB_XCNT(j)  (256  + 64 * (j))
#define XB_XSUB(j)  (1280 + 64 * (j))
#define XB_XGEN(j)  (2304 + 64 * (j))
#define XB_TOP      3328
#define XB_TOPGEN   3392
#define XCD_BAR_WORDS 3456
#define XB_SPIN_CAP (1u << 18)
#define LAS __attribute__((address_space(3)))
__device__ __forceinline__ unsigned xb_ld(unsigned* p)              { return __hip_atomic_load(p, __ATOMIC_RELAXED, __HIP_MEMORY_SCOPE_AGENT); }
__device__ __forceinline__ unsigned xb_add(unsigned* p, unsigned v) { return __hip_atomic_fetch_add(p, v, __ATOMIC_RELAXED, __HIP_MEMORY_SCOPE_AGENT); }
__device__ __forceinline__ unsigned xb_xcc_id() { return (unsigned)__builtin_amdgcn_s_getreg((3 << 11) | 20) & 0xFu; }
#define XB_SPIN(cond, bar) do { unsigned _sp = 0; while (cond) { __builtin_amdgcn_s_sleep(1); \
    if ((++_sp & 255u) == 0u) { if (xb_ld(&(bar)[XB_TMO])) break; if (_sp > XB_SPIN_CAP) { atomicAdd(&(bar)[XB_TMO], 1u); break; } } } } while (0)
struct XcdBarrier { unsigned* bar; unsigned x; volatile LAS unsigned* st; };
__device__ __forceinline__ XcdBarrier xcd_barrier_post(unsigned* bar, volatile LAS unsigned* st) {
    XcdBarrier b; b.bar = bar; b.x = xb_xcc_id(); b.st = st;
    if (threadIdx.x == 0) (void)xb_add(&bar[XB_XCNT(b.x)], 1u);
    return b;
}
__device__ __forceinline__ void xcd_barrier_complete(unsigned* bar, unsigned x, unsigned& nloc, unsigned& nx) {
    const unsigned G = gridDim.x * gridDim.y * gridDim.z;
    unsigned sum, cnt, mine, sp = 0u;
    for (;;) {
        sum = 0u; cnt = 0u; mine = 0u;
#pragma unroll
        for (unsigned j = 0; j < 16; ++j) { const unsigned c = xb_ld(&bar[XB_XCNT(j)]); sum += c; cnt += (c > 0u) ? 1u : 0u; mine = (j == x) ? c : mine; }
        if (sum == G) break;
        __builtin_amdgcn_s_sleep(1);
        if ((++sp & 255u) == 0u) { if (xb_ld(&bar[XB_TMO])) break; if (sp > XB_SPIN_CAP) { atomicAdd(&bar[XB_TMO], 1u); break; } }
    }
    nloc = mine > 0u ? mine : 1u; nx = cnt > 0u ? cnt : 1u;
}
template <bool INV>
__device__ __forceinline__ void xcd_barrier(const XcdBarrier& b) {
    asm volatile("s_waitcnt vmcnt(0)" ::: "memory");
    __syncthreads();
    if (threadIdx.x == 0) {
        unsigned* bar = b.bar;
        __builtin_amdgcn_s_waitcnt(0);
        unsigned nloc = b.st[0], nx = b.st[1];
        if (nloc == 0u) { xcd_barrier_complete(bar, b.x, nloc, nx); b.st[0] = nloc; b.st[1] = nx; }
        const unsigned old = xb_add(&bar[XB_XSUB(b.x)], 1u);
        const unsigned gen = old / nloc;
        if (old + 1u == (gen + 1u) * nloc) {
            __builtin_amdgcn_fence(__ATOMIC_RELEASE, "agent");
            asm volatile("s_waitcnt vmcnt(0)" ::: "memory");
            const unsigned og = xb_add(&bar[XB_TOP], 1u);
            const unsigned tg = og / nx;
            if (og + 1u == (tg + 1u) * nx) xb_add(&bar[XB_TOPGEN], 1u);
            else XB_SPIN(xb_ld(&bar[XB_TOPGEN]) == tg, bar);
            if (INV) __builtin_amdgcn_fence(__ATOMIC_ACQUIRE, "agent");
            xb_add(&bar[XB_XGEN(b.x)], 1u);
            asm volatile("s_waitcnt vmcnt(0)" ::: "memory");
        } else {
            XB_SPIN(xb_ld(&bar[XB_XGEN(b.x)]) == gen, bar);
            if (INV) __builtin_amdgcn_fence(__ATOMIC_ACQUIRE, "agent");
            asm volatile("s_waitcnt vmcnt(0)" ::: "memory");
        }
    }
    __syncthreads();
}

template <int S>
__device__ __forceinline__ void run_step(PRef P, int l, char* lds) {
  if constexpr (S == 0) phase0a(P, lds);
  else if constexpr (S == 1) phase0b(P);
  else if constexpr (S == 2) normmod_phase(P, l, 0);
  else if constexpr (S == 3) win_phase(P, l, lds);
  else if constexpr (S == 4) mixa_phase(P, l, lds);
  else if constexpr (S == 5) carry_phase(P, l);
  else if constexpr (S == 6) mixb_phase(P, l, lds);
  else if constexpr (S == 7) gluc_phase(P, l, lds);
  else if constexpr (S == 8) wout_phase(P, l, lds);
  else if constexpr (S == 9) normmod_phase(P, l, 1);
  else if constexpr (S == 10) mlp1_phase(P, l, lds);
  else if constexpr (S == 11) mlp2_phase(P, l, lds);
  else if constexpr (S == 13) mlp2_phase<true>(P, l, lds);
  else if constexpr (S == 15) mlp1_dummy_phase<true>(P, l, lds);
  else if constexpr (S == 16) mlp1_dummy_phase<false>(P, l, lds);
  else if constexpr (S == 14) wout_phase<true>(P, l, lds);
  else final_phase(P);
}

#if ONE_LAUNCH
__device__ __forceinline__ PPtr kparams() {
  PPtr pp = (PPtr)__builtin_amdgcn_kernarg_segment_ptr();
  asm volatile("" : "+s"(pp));
  return pp;
}
#define RUN(S_, l_) run_step<S_>(*kparams(), l_, lds)
__global__ void __launch_bounds__(256, 3) mega(Params Pv) {
  __shared__ __attribute__((aligned(16))) char lds[45056];
  __shared__ uint4 xb_words;
  if (threadIdx.x == 0) xb_words = make_uint4(0u, 0u, 0u, 0u);
  __syncthreads();
  (void)xcd_barrier_post(kparams()->bar, (volatile LAS unsigned*)&xb_words);
#define GSYNC_(INV_) do { XcdBarrier xb_; xb_.bar = kparams()->bar; xb_.x = xb_xcc_id(); xb_.st = (volatile LAS unsigned*)&xb_words; xcd_barrier<INV_>(xb_); } while (0)
#define GSYNC() GSYNC_(false)
#define GSYNCI() GSYNC_(true)
  RUN(0, 0);
  if (kparams()->use_cg) cg::this_grid().sync();
  GSYNC();
#pragma nounroll
  for (int l = 0; l < 2; ++l) {
    RUN(2, l); GSYNC();
    RUN(3, l); GSYNCI();
    RUN(4, l); GSYNC();
    RUN(5, l); GSYNC();
    RUN(6, l); GSYNC();
    RUN(7, l); GSYNC();
    RUN(8, l); GSYNC();
    RUN(9, l); GSYNC();
    RUN(10, l); GSYNCI();
    RUN(11, l); GSYNC();
  }
  RUN(12, 0);
}
#else
template <int S>
__global__ void __launch_bounds__(256, 2) step_kernel(Params Pv, int l) {
  __shared__ __attribute__((aligned(16))) char lds[45056];
  run_step<S>(*(PPtr)__builtin_amdgcn_kernarg_segment_ptr(), l, lds);
}
#endif

extern "C" void kernel_launch(void* const* d_in, const int* in_sizes, int n_in, void* d_out, int out_size, void* d_ws, size_t ws_size,
                              hipStream_t stream) {
  Params P{};
  const float** pin = (const float**)&P;
  for (int i = 0; i < 30; ++i) pin[i] = (const float*)d_in[i];
  P.out = (float*)d_out;
  char* ws = (char*)d_ws;
  size_t off = 0;
  auto alloc = [&](size_t bytes) { char* p = ws + off; off += (bytes + 255) & ~(size_t)255; return p; };
  P.wt_in = (bf16_t*)alloc((size_t)2 * 3072 * 1024 * 2);
  P.wt_out = (bf16_t*)alloc((size_t)2 * 1024 * 1024 * 2);
  P.wt_m1 = (bf16_t*)alloc((size_t)2 * 4096 * 1024 * 2);
  P.wt_m2 = (bf16_t*)alloc((size_t)2 * 4096 * 1024 * 2);
  P.wt_glu = (bf16_t*)alloc((size_t)2 * 256 * 256 * 2);
  P.adap = (float*)alloc((size_t)2 * 16 * 3 * 6144 * 4);
  P.uedge = (float*)alloc((size_t)16 * 2 * 256 * 4);
  P.z = (bf16_t*)alloc((size_t)NTOK * 4096 * 2);
  P.hid = P.z;
  P.h = (bf16_t*)alloc((size_t)NTOK * 1024 * 2);
  P.mix = (bf16_t*)alloc((size_t)NTOK * 1024 * 2);
  P.xg = (bf16_t*)alloc((size_t)NTOK * 256 * 2);
  P.ckb = (bf16_t*)alloc((size_t)2 * 2 * 512 * 512 * 2);
  P.cvb = (bf16_t*)alloc((size_t)2 * 2 * 512 * 512 * 2);
  P.apow = (float2*)alloc((size_t)64 * 64 * 33 * 8);
  P.bbar = (float2*)alloc((size_t)64 * 64 * 16 * 8);
  P.ktab = (float*)alloc((size_t)64 * 8192 * 4);
  P.atab = (bf16_t*)alloc((size_t)32 * 512 * 768 * 2);
  P.wtab = (bf16_t*)alloc((size_t)32 * 256 * 512 * 2);
  P.bts5 = (bf16_t*)alloc((size_t)16 * 256 * 768 * 2);
  P.E = (float*)alloc((size_t)16 * 256 * 192 * 4);
  P.kv = (float*)alloc((size_t)768 * 4096 * 4);
  P.gdec = (float*)alloc((size_t)768 * 64 * 4);
  P.sst = (float*)alloc((size_t)768 * 4096 * 4);
  P.obuf = (float*)alloc((size_t)2 * NTOK * 256 * 4);
  P.pbuf = P.kv;
  P.bar = (unsigned*)alloc((size_t)XCD_BAR_WORDS * 4);
  P.mod = (float*)alloc((size_t)2 * 3 * 6144 * 4);
  const size_t zero_bytes = (size_t)((char*)P.mod - (char*)P.bar) + (size_t)2 * 3 * 6144 * 4;
  if (off > ws_size) { fprintf(stderr, "workspace too small: need %zu have %zu\n", off, ws_size); return; }

#if ONE_LAUNCH
  static int grid_blocks = 0;
  if (!grid_blocks) {
    int dev = 0, cus = 0, per_cu = 0;
    (void)hipGetDevice(&dev);
    (void)hipDeviceGetAttribute(&cus, hipDeviceAttributeMultiprocessorCount, dev);
    (void)hipOccupancyMaxActiveBlocksPerMultiprocessor(&per_cu, mega, 256, 0);
    if (per_cu < 1) per_cu = 1;
    if (per_cu > 4) per_cu = 4;
    grid_blocks = cus * per_cu;
  }
  (void)hipMemsetAsync(P.bar, 0, zero_bytes, stream);
  void* args[] = {&P};
  hipError_t e = hipLaunchCooperativeKernel((void*)mega, dim3(grid_blocks), dim3(256), args, 0, stream);
  if (e != hipSuccess) fprintf(stderr, "cooperative launch failed: %s (grid %d)\n", hipGetErrorString(e), grid_blocks);
#else
  const int grid_blocks = 512;
  step_kernel<0><<<grid_blocks, 256, 0, stream>>>(P, 0);
  step_kernel<1><<<grid_blocks, 256, 0, stream>>>(P, 0);
  for (int l = 0; l < 2; ++l) {
    step_kernel<2><<<grid_blocks, 256, 0, stream>>>(P, l);
    step_kernel<3><<<grid_blocks, 256, 0, stream>>>(P, l);
    step_kernel<4><<<grid_blocks, 256, 0, stream>>>(P, l);
    step_kernel<5><<<grid_blocks, 256, 0, stream>>>(P, l);
    step_kernel<6><<<grid_blocks, 256, 0, stream>>>(P, l);
    step_kernel<7><<<grid_blocks, 256, 0, stream>>>(P, l);
    step_kernel<8><<<grid_blocks, 256, 0, stream>>>(P, l);
    step_kernel<9><<<grid_blocks, 256, 0, stream>>>(P, l);
    step_kernel<10><<<grid_blocks, 256, 0, stream>>>(P, l);
    step_kernel<11><<<grid_blocks, 256, 0, stream>>>(P, l);
  }
  step_kernel<12><<<grid_blocks, 256, 0, stream>>>(P, 0);
#endif
}
```
